# Optimizing an MI355X kernel written in HIP

```python
import jax, jax.numpy as jnp
from jax import lax
import numpy as np

D_MODEL = 2048
BATCH = 2
SEQ = 4096
DEPTH = 4

N_MIXERS = 2
N_RGLRU = (DEPTH + 1) // 2
N_RWKV = DEPTH // 2
D_FF = 4 * D_MODEL
D_RNN = D_MODEL
RG_HEADS = 8
RG_BLOCK = D_RNN // RG_HEADS
CONV_W = 4
RG_C = 8.0
RW_HEAD = 64
RW_HEADS = D_MODEL // RW_HEAD
DECAY_LORA = 96
AAA_LORA = 96
GATE_LORA = 256
RMS_EPS = 1e-6
GN_EPS = 64e-5

kernel_name = 'hybrid_rglru_rwkv7_sqrelu_trunk'


def rmsnorm(x, g):
    xf = x.astype(jnp.float32)
    y = xf * lax.rsqrt(jnp.mean(xf * xf, axis=-1, keepdims=True) + RMS_EPS)
    return (y * g.astype(jnp.float32)).astype(x.dtype)


def causal_depthwise_conv(x, w, b):
    s = x.shape[1]
    xp = jnp.pad(x, ((0, 0), (CONV_W - 1, 0), (0, 0)))
    out = b
    for k in range(CONV_W):
        out = out + w[k] * xp[:, k:k + s]
    return out


def block_diag_linear(x, w, b):
    xb = x.reshape(x.shape[:-1] + (RG_HEADS, RG_BLOCK))
    return jnp.einsum('bshi,hij->bshj', xb, w).reshape(x.shape) + b


def rglru_block(x, w_in, conv_w, conv_b, gx_w, gx_b, ga_w, ga_b, lam, w_out):
    proj = x @ w_in
    gate_branch, rec = jnp.split(proj, 2, axis=-1)
    rec = causal_depthwise_conv(rec, conv_w, conv_b)
    recf = rec.astype(jnp.float32)
    i_t = jax.nn.sigmoid(block_diag_linear(recf, gx_w, gx_b).astype(jnp.float32))
    r_t = jax.nn.sigmoid(block_diag_linear(recf, ga_w, ga_b).astype(jnp.float32))
    log_a = RG_C * r_t * jax.nn.log_sigmoid(lam.astype(jnp.float32))
    a_t = jnp.exp(log_a)
    mult = jnp.sqrt(jnp.maximum(-jnp.expm1(2.0 * log_a), 0.0))
    b_t = mult * (i_t * recf)

    def combine(e1, e2):
        a1, b1 = e1
        a2, b2 = e2
        return a1 * a2, a2 * b1 + b2

    _, h = lax.associative_scan(combine, (a_t, b_t), axis=1)
    y = h.astype(x.dtype) * jax.nn.gelu(gate_branch)
    return y @ w_out


def rwkv7_time_mix(x, mu, w_rkv, w0, w1, w2, a0, a1, a2, g1, g2,
                   k_k, k_a, r_k, ln_g, ln_b, w_out):
    bsz, s, d = x.shape
    f32 = jnp.float32
    xx = jnp.pad(x, ((0, 0), (1, 0), (0, 0)))[:, :-1] - x
    xm = x[:, :, None, :] + xx[:, :, None, :] * mu
    rkv = jnp.einsum('bsjd,jde->bsje', xm[:, :, :3], w_rkv)
    r, k, v = rkv[:, :, 0], rkv[:, :, 1], rkv[:, :, 2]
    xw, xa, xg = xm[:, :, 3], xm[:, :, 4], xm[:, :, 5]
    w = -jax.nn.softplus(-(w0 + jnp.tanh(xw @ w1) @ w2)) - 0.5
    decay = jnp.exp(-jnp.exp(w.astype(f32)))
    a = jax.nn.sigmoid((a0 + (xa @ a1) @ a2).astype(f32))
    g = jax.nn.sigmoid(xg @ g1) @ g2

    def heads(t):
        return t.astype(f32).reshape(bsz, s, RW_HEADS, RW_HEAD)

    kk = heads(k * k_k)
    kk = kk / jnp.maximum(jnp.sqrt(jnp.sum(kk * kk, axis=-1, keepdims=True)), 1e-12)
    k_mod = k.astype(f32) * (1.0 + (a - 1.0) * k_a.astype(f32))
    r_h, k_h, v_h, w_h, a_h = heads(r), heads(k_mod), heads(v), heads(decay), heads(a)

    def step(state, inp):
        r_t, w_t, k_t, v_t, kk_t, a_t = inp
        sa = jnp.einsum('bhij,bhj->bhi', state, kk_t)
        state = (state * w_t[:, :, None, :]
                 - sa[..., None] * (kk_t * a_t)[:, :, None, :]
                 + v_t[..., None] * k_t[:, :, None, :])
        y_t = jnp.einsum('bhij,bhj->bhi', state, r_t)
        return state, y_t

    xs = tuple(jnp.moveaxis(t, 1, 0) for t in (r_h, w_h, k_h, v_h, kk, a_h))
    state0 = jnp.zeros((bsz, RW_HEADS, RW_HEAD, RW_HEAD), f32)
    _, y = lax.scan(step, state0, xs)
    y = jnp.moveaxis(y, 0, 1)
    mean = jnp.mean(y, axis=-1, keepdims=True)
    var = jnp.mean(jnp.square(y - mean), axis=-1, keepdims=True)
    y = (y - mean) * lax.rsqrt(var + GN_EPS)
    y = y.reshape(bsz, s, d) * ln_g.astype(f32) + ln_b.astype(f32)
    bonus = jnp.sum(r_h * k_h * r_k.astype(f32), axis=-1, keepdims=True) * v_h
    y = y + bonus.reshape(bsz, s, d)
    return (y * g.astype(f32)).astype(x.dtype) @ w_out


def sq_relu_mlp(x, w_up, w_down):
    return jnp.square(jax.nn.relu(x @ w_up)) @ w_down


def setup_inputs(seed: int = 0) -> dict:
    key = jax.random.key(seed)
    ks = jax.random.split(key, 40)
    f32 = jnp.float32

    def nrm(k, shape, scale):
        return jax.random.normal(k, shape, f32) * scale

    x = jax.random.normal(ks[0], (BATCH, SEQ, D_MODEL), f32)
    norm_mix_g = 1.0 + nrm(ks[1], (DEPTH, D_MODEL), 0.02)
    norm_mlp_g = 1.0 + nrm(ks[2], (DEPTH, D_MODEL), 0.02)
    w_mlp_up = nrm(ks[3], (DEPTH, D_MODEL, D_FF), D_MODEL ** -0.5)
    w_mlp_down = nrm(ks[4], (DEPTH, D_FF, D_MODEL), 0.5 * D_FF ** -0.5)
    final_norm_g = 1.0 + nrm(ks[5], (D_MODEL,), 0.02)
    rg_w_in = nrm(ks[6], (N_RGLRU, D_MODEL, 2 * D_RNN), D_MODEL ** -0.5)
    rg_conv_w = nrm(ks[7], (N_RGLRU, CONV_W, D_RNN), CONV_W ** -0.5)
    rg_conv_b = nrm(ks[8], (N_RGLRU, D_RNN), 0.02)
    rg_gx_w = nrm(ks[9], (N_RGLRU, RG_HEADS, RG_BLOCK, RG_BLOCK), RG_BLOCK ** -0.5)
    rg_gx_b = nrm(ks[10], (N_RGLRU, D_RNN), 0.1)
    rg_ga_w = nrm(ks[11], (N_RGLRU, RG_HEADS, RG_BLOCK, RG_BLOCK), RG_BLOCK ** -0.5)
    rg_ga_b = nrm(ks[12], (N_RGLRU, D_RNN), 0.1)
    u = jax.random.uniform(ks[13], (N_RGLRU, D_RNN), f32, minval=0.9, maxval=0.999)
    sgm = u ** (1.0 / RG_C)
    rg_lambda = jnp.log(sgm) - jnp.log1p(-sgm)
    rg_w_out = nrm(ks[14], (N_RGLRU, D_RNN, D_MODEL), 0.5 * D_RNN ** -0.5)
    rw_mu = jax.random.uniform(ks[15], (N_RWKV, 6, D_MODEL), f32)
    rw_w_rkv = nrm(ks[16], (N_RWKV, 3, D_MODEL, D_MODEL), D_MODEL ** -0.5)
    ratio = jnp.arange(D_MODEL, dtype=f32) / (D_MODEL - 1)
    rw_w0 = -6.0 + 5.0 * ratio ** 1.35 + nrm(ks[17], (N_RWKV, D_MODEL), 0.1)
    rw_w1 = nrm(ks[18], (N_RWKV, D_MODEL, DECAY_LORA), D_MODEL ** -0.5)
    rw_w2 = nrm(ks[19], (N_RWKV, DECAY_LORA, D_MODEL), 0.3 * DECAY_LORA ** -0.5)
    rw_a0 = nrm(ks[20], (N_RWKV, D_MODEL), 0.1)
    rw_a1 = nrm(ks[21], (N_RWKV, D_MODEL, AAA_LORA), D_MODEL ** -0.5)
    rw_a2 = nrm(ks[22], (N_RWKV, AAA_LORA, D_MODEL), 0.5 * AAA_LORA ** -0.5)
    rw_g1 = nrm(ks[23], (N_RWKV, D_MODEL, GATE_LORA), D_MODEL ** -0.5)
    rw_g2 = nrm(ks[24], (N_RWKV, GATE_LORA, D_MODEL), GATE_LORA ** -0.5)
    rw_k_k = 0.85 + nrm(ks[25], (N_RWKV, D_MODEL), 0.05)
    rw_k_a = 1.0 + nrm(ks[26], (N_RWKV, D_MODEL), 0.05)
    rw_r_k = nrm(ks[27], (N_RWKV, RW_HEADS, RW_HEAD), 0.1)
    rw_ln_g = 1.0 + nrm(ks[28], (N_RWKV, D_MODEL), 0.02)
    rw_ln_b = nrm(ks[29], (N_RWKV, D_MODEL), 0.02)
    rw_w_out = nrm(ks[30], (N_RWKV, D_MODEL, D_MODEL), 0.5 * D_MODEL ** -0.5)
    return {
        'x': x, 'norm_mix_g': norm_mix_g, 'norm_mlp_g': norm_mlp_g,
        'w_mlp_up': w_mlp_up, 'w_mlp_down': w_mlp_down, 'final_norm_g': final_norm_g,
        'rg_w_in': rg_w_in, 'rg_conv_w': rg_conv_w, 'rg_conv_b': rg_conv_b,
        'rg_gx_w': rg_gx_w, 'rg_gx_b': rg_gx_b, 'rg_ga_w': rg_ga_w, 'rg_ga_b': rg_ga_b,
        'rg_lambda': rg_lambda, 'rg_w_out': rg_w_out,
        'rw_mu': rw_mu, 'rw_w_rkv': rw_w_rkv, 'rw_w0': rw_w0, 'rw_w1': rw_w1, 'rw_w2': rw_w2,
        'rw_a0': rw_a0, 'rw_a1': rw_a1, 'rw_a2': rw_a2, 'rw_g1': rw_g1, 'rw_g2': rw_g2,
        'rw_k_k': rw_k_k, 'rw_k_a': rw_k_a, 'rw_r_k': rw_r_k,
        'rw_ln_g': rw_ln_g, 'rw_ln_b': rw_ln_b, 'rw_w_out': rw_w_out,
    }


def reference(x, norm_mix_g, norm_mlp_g, w_mlp_up, w_mlp_down, final_norm_g,
              rg_w_in, rg_conv_w, rg_conv_b, rg_gx_w, rg_gx_b, rg_ga_w, rg_ga_b,
              rg_lambda, rg_w_out,
              rw_mu, rw_w_rkv, rw_w0, rw_w1, rw_w2, rw_a0, rw_a1, rw_a2, rw_g1, rw_g2,
              rw_k_k, rw_k_a, rw_r_k, rw_ln_g, rw_ln_b, rw_w_out):
    h = x
    for i in range(DEPTH):
        hn = rmsnorm(h, norm_mix_g[i])
        j = i // N_MIXERS
        if i % N_MIXERS == 0:
            mix = rglru_block(hn, rg_w_in[j], rg_conv_w[j], rg_conv_b[j],
                              rg_gx_w[j], rg_gx_b[j], rg_ga_w[j], rg_ga_b[j],
                              rg_lambda[j], rg_w_out[j])
        else:
            mix = rwkv7_time_mix(hn, rw_mu[j], rw_w_rkv[j], rw_w0[j], rw_w1[j], rw_w2[j],
                                 rw_a0[j], rw_a1[j], rw_a2[j], rw_g1[j], rw_g2[j],
                                 rw_k_k[j], rw_k_a[j], rw_r_k[j],
                                 rw_ln_g[j], rw_ln_b[j], rw_w_out[j])
        h = h + mix
        hn = rmsnorm(h, norm_mlp_g[i])
        h = h + sq_relu_mlp(hn, w_mlp_up[i], w_mlp_down[i])
    return rmsnorm(h, final_norm_g)
```

```cpp
#include <hip/hip_runtime.h>
#include <hip/hip_cooperative_groups.h>
#include <cstdio>
#include <cstdint>
namespace cg = cooperative_groups;

#ifndef N_LAUNCH_PER_PHASE
#define N_LAUNCH_PER_PHASE 0
#endif

#ifndef KMASK
#define KMASK 0xffffffu
#endif
#define KEN(n) (((KMASK) >> (n)) & 1u)
#ifndef REPMASK
#define REPMASK 0u
#endif
#define LAS __attribute__((address_space(3)))
typedef unsigned short bf16_t;
typedef short bf16x8 __attribute__((ext_vector_type(8)));
typedef float f32x4 __attribute__((ext_vector_type(4)));
typedef float f32x2 __attribute__((ext_vector_type(2)));
typedef unsigned u32x2 __attribute__((ext_vector_type(2)));
typedef unsigned u32x4 __attribute__((ext_vector_type(4)));

constexpr int T = 8192, D = 2048, S = 4096, FF = 8192;
constexpr size_t MiB = 1ull << 20;
constexpr size_t TD = (size_t)T * D;
constexpr size_t SZ_W_RG = 26 * MiB;
constexpr size_t SZ_W_RW = 38 * MiB;
constexpr size_t SZ_W_MLP = 64 * MiB;
constexpr size_t OFF_W_RG = 0;
constexpr size_t OFF_W_RW = OFF_W_RG + 2 * SZ_W_RG;
constexpr size_t OFF_W_MLP = OFF_W_RW + 2 * SZ_W_RW;
constexpr size_t OFF_H = OFF_W_MLP + 4 * SZ_W_MLP;
constexpr size_t OFF_ACTA = OFF_H + 64 * MiB;
constexpr size_t OFF_X = OFF_ACTA + 32 * MiB;
constexpr size_t OFF_XM = OFF_X;
constexpr size_t OFF_DEC = OFF_X, OFF_AA = OFF_X + 64 * MiB, OFF_GG = OFF_X + 128 * MiB;
constexpr size_t OFF_R = OFF_X + 192 * MiB, OFF_K = OFF_R + 64 * MiB, OFF_V = OFF_K + 64 * MiB;
constexpr size_t OFF_LORA = OFF_X + 384 * MiB;
constexpr size_t OFF_YREC = OFF_X + 396 * MiB;
constexpr size_t OFF_GATE = OFF_X, OFF_REC = OFF_X + 64 * MiB, OFF_CV = OFF_X + 128 * MiB, OFF_CVB = OFF_X + 192 * MiB;
constexpr size_t OFF_AT = OFF_X + 224 * MiB, OFF_BT = OFF_X + 288 * MiB, OFF_AGGA = OFF_X + 352 * MiB, OFF_AGGH = OFF_X + 353 * MiB;
constexpr size_t OFF_U = OFF_X;
constexpr size_t OFF_H2 = OFF_X + 460 * MiB;
constexpr size_t OFF_BAR = OFF_H2 + 64 * MiB;
constexpr size_t OFF_BON = OFF_BAR + 1 * MiB;
constexpr size_t WS_END = OFF_BON + 1 * MiB;

constexpr int LDS_ST_OFF = 151552;
constexpr int LDS_BYTES = LDS_ST_OFF + 64;

struct Params {
    const float* in[31];
    float* out;
    unsigned char* ws;
    int ph_lo, ph_hi;
};

__device__ __forceinline__ const float* in_ptr(const Params& P, int i) { asm volatile("" : "+s"(i)); return P.in[i]; }
__device__ __forceinline__ unsigned cvt_pk_bf16(float lo, float hi) { unsigned r; asm volatile("v_cvt_pk_bf16_f32 %0, %1, %2" : "=v"(r) : "v"(lo), "v"(hi)); return r; }
__device__ __forceinline__ u32x2 pack4(f32x4 v) { u32x2 o; o.x = cvt_pk_bf16(v.x, v.y); o.y = cvt_pk_bf16(v.z, v.w); return o; }
__device__ __forceinline__ f32x4 unpack4(u32x2 u) { f32x4 o; o.x = __uint_as_float(u.x << 16); o.y = __uint_as_float(u.x & 0xffff0000u); o.z = __uint_as_float(u.y << 16); o.w = __uint_as_float(u.y & 0xffff0000u); return o; }
__device__ __forceinline__ void unpack8(u32x4 u, f32x4& a, f32x4& b) { a = unpack4((u32x2){u.x, u.y}); b = unpack4((u32x2){u.z, u.w}); }
__device__ __forceinline__ float wave_sum(float v) {
#pragma unroll
    for (int o = 1; o < 64; o <<= 1) v += __shfl_xor(v, o);
    return v;
}
__device__ __forceinline__ float sigmoidf_(float x) { return __builtin_amdgcn_rcpf(1.f + __expf(-x)); }
__device__ __forceinline__ float tanhf_(float x) { const float xc = fminf(fmaxf(x, -15.f), 15.f); return 1.f - 2.f * __builtin_amdgcn_rcpf(1.f + __expf(2.f * xc)); }
__device__ __forceinline__ float gelu_tanh(float x) { const float u = 0.7978845608028654f * (x + 0.044715f * x * x * x); return 0.5f * x * (1.f + tanhf_(u)); }
__device__ __forceinline__ float neg_expm1(float x) { return (fabsf(x) < 0.02f) ? -x * (1.f + x * (0.5f + x * (0.16666667f + x * 0.041666668f))) : 1.f - __expf(x); }
__device__ __forceinline__ int otid() { int t; asm volatile("v_mov_b32 %0, %1" : "=v"(t) : "v"((int)threadIdx.x)); return t; }
__device__ __forceinline__ int obid() { int t; asm volatile("s_mov_b32 %0, %1" : "=s"(t) : "s"((int)blockIdx.x)); return t; }
template <int CTRL> __device__ __forceinline__ float dpp_f(float v) { return __builtin_bit_cast(float, __builtin_amdgcn_update_dpp(0, __builtin_bit_cast(int, v), CTRL, 0xf, 0xf, false)); }
__device__ __forceinline__ float row16_allsum(float p) {
    p += dpp_f<0x128>(p); p += dpp_f<0x124>(p); p += dpp_f<0x122>(p); p += dpp_f<0x121>(p); return p;
}

namespace pg8 {
constexpr int BM = 256, BK = 64, HALF = 128, HTB = HALF * BK * 2, STAGE_BYTES = 8 * HTB, NXCD = 8, WGM = 8;
__host__ __device__ __forceinline__ int lds_byte(int r, int c) { const int st = (r >> 4) * 2 + (c >> 5), rr = r & 15, cc = c & 31, ob = rr * 64 + cc * 2; return st * 1024 + (ob ^ (((ob >> 9) & 1) << 5)); }
__host__ __device__ __forceinline__ void stage_rc(int b, int& R, int& C) { const int st = b / 1024, sb = b % 1024, swz = sb ^ (((sb >> 9) & 1) << 5); R = (st >> 1) * 16 + swz / 64; C = (st & 1) * 32 + (swz % 64) / 2; }
__host__ __device__ __forceinline__ int perm32(int rho) { const int n = rho >> 4, i = rho & 15; return 8 * (i >> 2) + 4 * n + (i & 3); }
struct Unit { int pm, pn; };
struct Gemm { const bf16_t* A; const bf16_t* Bt; int M, N, K, lda, ldb; };
template <int AMODE> struct Order {
    int nM, nN, nwg, G, c;
    __device__ void init(int M, int N, int G_, int c_) { nM = M / BM; nN = N / BM; nwg = nM * nN; G = G_; c = c_; }
    __device__ bool next(int i, Unit& u) const {
        const long L = (long)i * G + c; if (L >= nwg) return false;
        int wgid = (int)L; { const int q = nwg / NXCD, r = nwg % NXCD, xcd = wgid % NXCD, off = wgid / NXCD; wgid = (xcd < r ? xcd * (q + 1) : r * (q + 1) + (xcd - r) * q) + off; }
        const int nig = WGM * nN, gid = wgid / nig, fm = gid * WGM, gsz = (nM - fm) < WGM ? (nM - fm) : WGM;
        u.pm = fm + ((wgid % nig) % gsz); u.pn = (wgid % nig) / gsz; return true;
    }
    __device__ __forceinline__ size_t a_off(const Unit& u) const {
        if (AMODE == 1) return (size_t)(u.pn >> 1) * 512;
        if (AMODE == 2) { const int w = u.pn < 24 ? (u.pn >> 3) : (u.pn - 21); return (size_t)w * TD * 2; }
        if (AMODE == 3) return (size_t)(u.pn >> 3) * ((size_t)T * 256 * 2);
        return 0;
    }
};

#ifndef PG8_SP2
#define PG8_SP2 true
#endif
#ifndef PG8_ALIGN
#define PG8_ALIGN true
#endif
template <class Epi, class Sched, bool ALIGN_EPI = PG8_ALIGN, bool SP2 = PG8_SP2>
__device__ __forceinline__ void gemm_phase(LAS unsigned char* lds, const Gemm g, const Sched& S, const Epi& E) {
    int tid; asm volatile("v_mov_b32 %0, %1" : "=v"(tid) : "v"((int)threadIdx.x));
    const int wid = __builtin_amdgcn_readfirstlane(tid >> 6), lane = tid & 63, wr = wid >> 2, wc = wid & 3, fr = lane & 15, fq = lane >> 4;
    const int K = g.K, nt = K / BK;
    unsigned voffA[2], voffB[2];
#pragma unroll
    for (int i = 0; i < 2; ++i) { int R, C; stage_rc(tid * 16 + i * 8192, R, C);
        const int Rb = Epi::PERM ? ((R & ~31) + perm32(R & 31)) : R;
        voffA[i] = (unsigned)(R * g.lda + C) * 2u; voffB[i] = (unsigned)(Rb * g.ldb + C) * 2u; }
    const size_t kstep = (size_t)(BK * 2);
    const size_t hstepA = (size_t)HALF * g.lda * 2, hstepB = (size_t)HALF * g.ldb * 2;
    const size_t tstepA = 2 * hstepA, tstepB = 2 * hstepB;
    const unsigned ldsw = (unsigned)wid * 1024u;
    const int aoff = lds_byte(wr * 64 + fr, fq * 8), boff = lds_byte(wc * 32 + fr, fq * 8);
#define PG8_SA(b, h) (((b) * 2 + (h)) * HTB)
#define PG8_SB(b, h) ((4 + (b) * 2 + (h)) * HTB)
#define PG8_STAGE(bufoff, gbase, voff) do { _Pragma("unroll") for (int _i = 0; _i < 2; ++_i) \
        __builtin_amdgcn_global_load_lds((const unsigned*)((const char*)(gbase) + (voff)[_i]), (LAS unsigned*)(lds + (bufoff) + ldsw + _i * 8192), 16, 0, 0); } while (0)
#define PG8_LDA(dst, b, h) do { _Pragma("unroll") for (int m = 0; m < 4; ++m) _Pragma("unroll") for (int k = 0; k < 2; ++k) dst[m][k] = *(const LAS bf16x8*)(lds + PG8_SA(b, h) + aoff + m * 2048 + k * 1024); } while (0)
#define PG8_LDB(dst, b, h) do { _Pragma("unroll") for (int n = 0; n < 2; ++n) _Pragma("unroll") for (int k = 0; k < 2; ++k) dst[n][k] = *(const LAS bf16x8*)(lds + PG8_SB(b, h) + boff + n * 2048 + k * 1024); } while (0)
#define PG8_MMA(ai, bj, At, Bt) do { __builtin_amdgcn_s_setprio(1); _Pragma("unroll") for (int m = 0; m < 4; ++m) _Pragma("unroll") for (int n = 0; n < 2; ++n) _Pragma("unroll") for (int k = 0; k < 2; ++k) \
        acc[ai][bj][m][n] = __builtin_amdgcn_mfma_f32_16x16x32_bf16(Bt[n][k], At[m][k], acc[ai][bj][m][n], 0, 0, 0); __builtin_amdgcn_s_setprio(0); } while (0)
#define PG8_WAIT_V(n) asm volatile("s_waitcnt vmcnt(" #n ")" ::: "memory")
#define PG8_WAIT_L(n) asm volatile("s_waitcnt lgkmcnt(" #n ")" ::: "memory")
#define PG8_BAR __builtin_amdgcn_s_barrier()
#define PG8_SCHED __builtin_amdgcn_sched_barrier(0)
    Unit cur, nxt; int ui = 0;
    if (!S.next(0, cur)) return;
    f32x4 acc[2][2][4][2];
#pragma unroll
    for (int a = 0; a < 2; ++a)
#pragma unroll
        for (int b = 0; b < 2; ++b)
#pragma unroll
            for (int m = 0; m < 4; ++m)
#pragma unroll
                for (int n = 0; n < 2; ++n) acc[a][b][m][n] = (f32x4){0.f, 0.f, 0.f, 0.f};
    bf16x8 At[4][2], B0[2][2], B1[2][2];
    const char* cA = (const char*)g.A + (size_t)cur.pm * tstepA + S.a_off(cur); const char* cB = (const char*)g.Bt + (size_t)cur.pn * tstepB;
    if constexpr (SP2) {
        PG8_STAGE(PG8_SB(0, 0), cB, voffB); PG8_STAGE(PG8_SB(0, 1), cB + hstepB, voffB); PG8_STAGE(PG8_SA(0, 0), cA, voffA); PG8_STAGE(PG8_SA(0, 1), cA + hstepA, voffA);
        if (wr == 1) PG8_BAR;
        PG8_WAIT_V(2); PG8_BAR;
        PG8_STAGE(PG8_SB(1, 0), cB + kstep, voffB); PG8_STAGE(PG8_SA(1, 0), cA + kstep, voffA); PG8_STAGE(PG8_SB(1, 1), cB + hstepB + kstep, voffB);
        PG8_WAIT_V(6); PG8_BAR;
    } else {
        PG8_STAGE(PG8_SB(0, 0), cB, voffB); PG8_STAGE(PG8_SA(0, 0), cA, voffA); PG8_STAGE(PG8_SB(0, 1), cB + hstepB, voffB); PG8_STAGE(PG8_SA(0, 1), cA + hstepA, voffA);
        if (wr == 1) PG8_BAR;
        PG8_WAIT_V(4); PG8_BAR;
        PG8_STAGE(PG8_SB(1, 0), cB + kstep, voffB); PG8_STAGE(PG8_SA(1, 0), cA + kstep, voffA); PG8_STAGE(PG8_SB(1, 1), cB + hstepB + kstep, voffB);
        PG8_WAIT_V(6); PG8_BAR;
    }
    for (;;) {
        const bool has_next = S.next(ui + 1, nxt);
        const char* nA = has_next ? (const char*)g.A + (size_t)nxt.pm * tstepA + S.a_off(nxt) : cA; const char* nB = has_next ? (const char*)g.Bt + (size_t)nxt.pn * tstepB : cB;
#pragma unroll 1
        for (int t = 0; t < nt; t += 2) {
            const bool last = (t == nt - 2);
            const char* a1 = cA + (size_t)(t + 1) * kstep;
            const char* a2 = last ? nA : cA + (size_t)(t + 2) * kstep; const char* b2 = last ? nB : cB + (size_t)(t + 2) * kstep;
            const char* a3 = a2 + kstep; const char* b3 = b2 + kstep;
            if constexpr (SP2) {
            PG8_LDB(B0, 0, 0); PG8_LDB(B1, 0, 1); PG8_SCHED; PG8_LDA(At, 0, 0); PG8_STAGE(PG8_SA(1, 1), a1 + hstepA, voffA);
            PG8_WAIT_V(8); PG8_WAIT_L(0); PG8_BAR; PG8_MMA(0, 0, At, B0); PG8_MMA(0, 1, At, B1); PG8_BAR; PG8_SCHED;
            PG8_LDA(At, 0, 1); PG8_STAGE(PG8_SB(0, 0), b2, voffB); PG8_STAGE(PG8_SB(0, 1), b2 + hstepB, voffB); PG8_STAGE(PG8_SA(0, 0), a2, voffA);
            PG8_WAIT_V(8); PG8_WAIT_L(0); PG8_BAR; PG8_MMA(1, 0, At, B0); PG8_MMA(1, 1, At, B1); PG8_BAR; PG8_SCHED;
            PG8_LDB(B0, 1, 0); PG8_LDB(B1, 1, 1); PG8_SCHED; PG8_LDA(At, 1, 0); PG8_STAGE(PG8_SA(0, 1), a2 + hstepA, voffA);
            PG8_WAIT_V(8); PG8_WAIT_L(0); PG8_BAR; PG8_MMA(0, 0, At, B0); PG8_MMA(0, 1, At, B1); PG8_BAR; PG8_SCHED;
            PG8_LDA(At, 1, 1); PG8_STAGE(PG8_SB(1, 0), b3, voffB); PG8_STAGE(PG8_SB(1, 1), b3 + hstepB, voffB); PG8_STAGE(PG8_SA(1, 0), a3, voffA);
            PG8_WAIT_V(8); PG8_WAIT_L(0); PG8_BAR; PG8_MMA(1, 0, At, B0); PG8_MMA(1, 1, At, B1); PG8_BAR; PG8_SCHED;
            } else {
            PG8_LDB(B0, 0, 0); PG8_SCHED; PG8_LDA(At, 0, 0); PG8_STAGE(PG8_SA(1, 1), a1 + hstepA, voffA);
            PG8_WAIT_L(8); PG8_BAR; PG8_WAIT_L(0); PG8_MMA(0, 0, At, B0); PG8_BAR; PG8_SCHED;
            PG8_LDB(B1, 0, 1); PG8_STAGE(PG8_SB(0, 0), b2, voffB);
            PG8_BAR; PG8_WAIT_L(0); PG8_MMA(0, 1, At, B1); PG8_BAR;
            PG8_LDA(At, 0, 1); PG8_STAGE(PG8_SA(0, 0), a2, voffA);
            PG8_BAR; PG8_WAIT_L(0); PG8_MMA(1, 0, At, B0); PG8_BAR; PG8_SCHED;
            PG8_STAGE(PG8_SB(0, 1), b2 + hstepB, voffB);
            PG8_WAIT_V(6); PG8_BAR; PG8_MMA(1, 1, At, B1); PG8_BAR;
            PG8_LDB(B0, 1, 0); PG8_SCHED; PG8_LDA(At, 1, 0); PG8_STAGE(PG8_SA(0, 1), a2 + hstepA, voffA);
            PG8_WAIT_L(8); PG8_BAR; PG8_WAIT_L(0); PG8_MMA(0, 0, At, B0); PG8_BAR; PG8_SCHED;
            PG8_LDB(B1, 1, 1); PG8_STAGE(PG8_SB(1, 0), b3, voffB);
            PG8_BAR; PG8_WAIT_L(0); PG8_MMA(0, 1, At, B1); PG8_BAR;
            PG8_LDA(At, 1, 1); PG8_STAGE(PG8_SA(1, 0), a3, voffA);
            PG8_BAR; PG8_WAIT_L(0); PG8_MMA(1, 0, At, B0); PG8_BAR; PG8_SCHED;
            PG8_STAGE(PG8_SB(1, 1), b3 + hstepB, voffB);
            PG8_WAIT_V(6); PG8_BAR; PG8_MMA(1, 1, At, B1); PG8_BAR;
                    }
        }
        if constexpr (ALIGN_EPI) { if (wr == 0) PG8_BAR; }
        E(acc, cur, wr, wc, fr, fq);
        if (!has_next) break;
#pragma unroll
        for (int a = 0; a < 2; ++a)
#pragma unroll
            for (int b = 0; b < 2; ++b)
#pragma unroll
                for (int m = 0; m < 4; ++m)
#pragma unroll
                    for (int n = 0; n < 2; ++n) acc[a][b][m][n] = (f32x4){0.f, 0.f, 0.f, 0.f};
        cur = nxt; cA = nA; cB = nB; ++ui;
        if constexpr (ALIGN_EPI) { if (wr == 1) PG8_BAR; }
    }
    PG8_WAIT_V(0);
    if constexpr (!ALIGN_EPI) { if (wr == 0) PG8_BAR; }
    PG8_BAR;
#undef PG8_SA
#undef PG8_SB
#undef PG8_STAGE
#undef PG8_LDA
#undef PG8_LDB
#undef PG8_MMA
#undef PG8_WAIT_V
#undef PG8_WAIT_L
#undef PG8_BAR
#undef PG8_SCHED
}
}
using pg8::Unit;
typedef f32x4 Acc[2][2][4][2];
__device__ __forceinline__ u32x4 pack8(f32x4 a, f32x4 b) { u32x4 o; o.x = cvt_pk_bf16(a.x, a.y); o.y = cvt_pk_bf16(a.z, a.w); o.z = cvt_pk_bf16(b.x, b.y); o.w = cvt_pk_bf16(b.z, b.w); return o; }

struct EpiResidual {
    static constexpr bool PERM = true;
    const float* src; float* out;
    __device__ __forceinline__ void operator()(const Acc& acc, const Unit& u, int wr, int wc, int fr, int fq) const {
        const int row0 = u.pm * 256 + wr * 64 + fr, col0 = u.pn * 256 + wc * 32 + 8 * fq;
#pragma unroll
        for (int ai = 0; ai < 2; ++ai)
#pragma unroll
            for (int m = 0; m < 4; ++m) { const size_t ro = (size_t)(row0 + ai * 128 + m * 16) * D + col0;
#pragma unroll
                for (int bj = 0; bj < 2; ++bj) { const size_t o = ro + bj * 128;
                    const f32x4 h0 = *(const f32x4*)(src + o) + acc[ai][bj][m][0], h1 = *(const f32x4*)(src + o + 4) + acc[ai][bj][m][1];
                    *(f32x4*)(out + o) = h0; *(f32x4*)(out + o + 4) = h1; } }
    }
};
struct EpiInProj {
    static constexpr bool PERM = true;
    bf16_t* gate; bf16_t* rec;
    __device__ __forceinline__ void operator()(const Acc& acc, const Unit& u, int wr, int wc, int fr, int fq) const {
        const bool isg = u.pn < 8; bf16_t* dst = isg ? gate : rec;
        const int row0 = u.pm * 256 + wr * 64 + fr, col0 = (u.pn & 7) * 256 + wc * 32 + 8 * fq;
#pragma unroll
        for (int ai = 0; ai < 2; ++ai)
#pragma unroll
            for (int m = 0; m < 4; ++m) { const size_t ro = (size_t)(row0 + ai * 128 + m * 16) * D + col0;
#pragma unroll
                for (int bj = 0; bj < 2; ++bj) { f32x4 v0 = acc[ai][bj][m][0], v1 = acc[ai][bj][m][1];
                    if (isg) {
#pragma unroll
                        for (int j = 0; j < 4; ++j) { v0[j] = gelu_tanh(v0[j]); v1[j] = gelu_tanh(v1[j]); } }
                    *(u32x4*)(dst + ro + bj * 128) = pack8(v0, v1); } }
    }
};
struct EpiGates {
    static constexpr bool PERM = true;
    const float* gxb; const float* gab; const float* lam; const bf16_t* cv; bf16_t* at; bf16_t* bt;
    __device__ __forceinline__ void operator()(const Acc& acc, const Unit& u, int wr, int wc, int fr, int fq) const {
        const int row0 = u.pm * 256 + wr * 64 + fr, ch0 = (u.pn >> 1) * 256 + (u.pn & 1) * 128 + wc * 32 + 8 * fq;
        u32x4 cvr[2][4];
#pragma unroll
        for (int ai = 0; ai < 2; ++ai)
#pragma unroll
            for (int m = 0; m < 4; ++m) cvr[ai][m] = *(const u32x4*)(cv + (size_t)(row0 + ai * 128 + m * 16) * D + ch0);
        f32x4 bx[2], ba[2], ls[2];
#pragma unroll
        for (int n = 0; n < 2; ++n) { bx[n] = *(const f32x4*)(gxb + ch0 + 4 * n); ba[n] = *(const f32x4*)(gab + ch0 + 4 * n); const f32x4 lm = *(const f32x4*)(lam + ch0 + 4 * n);
#pragma unroll
            for (int j = 0; j < 4; ++j) ls[n][j] = -8.f * ((lm[j] > 0.f) ? __logf(1.f + __expf(-lm[j])) : (-lm[j] + __logf(1.f + __expf(lm[j])))); }
#pragma unroll
        for (int ai = 0; ai < 2; ++ai)
#pragma unroll
            for (int m = 0; m < 4; ++m) { const size_t o = (size_t)(row0 + ai * 128 + m * 16) * D + ch0;
                f32x4 cvv[2]; unpack8(cvr[ai][m], cvv[0], cvv[1]); f32x4 av[2], bv[2];
#pragma unroll
                for (int n = 0; n < 2; ++n) { const f32x4 gi = acc[ai][0][m][n], gr = acc[ai][1][m][n];
#pragma unroll
                    for (int j = 0; j < 4; ++j) { const float it = sigmoidf_(gi[j] + bx[n][j]), rt = sigmoidf_(gr[j] + ba[n][j]);
                        const float la = rt * ls[n][j]; av[n][j] = la; bv[n][j] = __builtin_amdgcn_sqrtf(fmaxf(1.f - __expf(2.f * la), 0.f)) * (it * cvv[n][j]); } }
                *(u32x4*)(at + o) = pack8(av[0], av[1]); *(u32x4*)(bt + o) = pack8(bv[0], bv[1]); }
    }
};
struct EpiRKV {
    static constexpr bool PERM = true;
    unsigned char* rkv; bf16_t* lora;
    __device__ __forceinline__ void operator()(const Acc& acc, const Unit& u, int wr, int wc, int fr, int fq) const {
        const int row0 = u.pm * 256 + wr * 64 + fr;
        if (u.pn < 24) {
            bf16_t* dst = (bf16_t*)(rkv + (size_t)(u.pn >> 3) * (64 * MiB)); const int col0 = (u.pn & 7) * 256 + wc * 32 + 8 * fq;
#pragma unroll
            for (int ai = 0; ai < 2; ++ai)
#pragma unroll
                for (int m = 0; m < 4; ++m) { const size_t ro = (size_t)(row0 + ai * 128 + m * 16) * D + col0;
#pragma unroll
                    for (int bj = 0; bj < 2; ++bj) *(u32x4*)(dst + ro + bj * 128) = pack8(acc[ai][bj][m][0], acc[ai][bj][m][1]); }
        } else {
            const int w = u.pn - 24; bf16_t* dst = lora + (size_t)w * T * 256; const int col0 = wc * 32 + 8 * fq;
#pragma unroll
            for (int ai = 0; ai < 2; ++ai)
#pragma unroll
                for (int m = 0; m < 4; ++m) { const size_t ro = (size_t)(row0 + ai * 128 + m * 16) * 256 + col0;
#pragma unroll
                    for (int bj = 0; bj < 2; ++bj) { f32x4 v0 = acc[ai][bj][m][0], v1 = acc[ai][bj][m][1];
                        if (w == 0) {
#pragma unroll
                            for (int j = 0; j < 4; ++j) { v0[j] = tanhf_(v0[j]); v1[j] = tanhf_(v1[j]); }
                        } else if (w == 2) {
#pragma unroll
                            for (int j = 0; j < 4; ++j) { v0[j] = sigmoidf_(v0[j]); v1[j] = sigmoidf_(v1[j]); } }
                        *(u32x4*)(dst + ro + bj * 128) = pack8(v0, v1); } }
        }
    }
};
struct EpiLoraUp {
    static constexpr bool PERM = true;
    const float* w0; const float* a0; float* dec;
    __device__ __forceinline__ void operator()(const Acc& acc, const Unit& u, int wr, int wc, int fr, int fq) const {
        const int w = u.pn >> 3; float* dst = dec + (size_t)w * TD; const float* bias = (w == 0) ? w0 : a0;
        const int row0 = u.pm * 256 + wr * 64 + fr, col0 = (u.pn & 7) * 256 + wc * 32 + 8 * fq;
#pragma unroll
        for (int bj = 0; bj < 2; ++bj) { const int c = col0 + bj * 128; const f32x4 bb0 = *(const f32x4*)(bias + c), bb1 = *(const f32x4*)(bias + c + 4);
#pragma unroll
            for (int ai = 0; ai < 2; ++ai)
#pragma unroll
                for (int m = 0; m < 4; ++m) { f32x4 v0 = acc[ai][bj][m][0], v1 = acc[ai][bj][m][1]; const size_t o = (size_t)(row0 + ai * 128 + m * 16) * D + c;
                    if (w == 0) {
#pragma unroll
                        for (int j = 0; j < 4; ++j) { v0[j] = __expf(-0.6065306597126334f * sigmoidf_(v0[j] + bb0[j])); v1[j] = __expf(-0.6065306597126334f * sigmoidf_(v1[j] + bb1[j])); }
                    } else if (w == 1) {
#pragma unroll
                        for (int j = 0; j < 4; ++j) { v0[j] = sigmoidf_(v0[j] + bb0[j]); v1[j] = sigmoidf_(v1[j] + bb1[j]); }
                    }
                    if (w == 2) *(u32x4*)((bf16_t*)dst + o) = pack8(v0, v1);
                    else { *(f32x4*)(dst + o) = v0; *(f32x4*)(dst + o + 4) = v1; } } }
    }
};
struct EpiUp {
    static constexpr bool PERM = true;
    bf16_t* U;
    __device__ __forceinline__ void operator()(const Acc& acc, const Unit& u, int wr, int wc, int fr, int fq) const {
        const int row0 = u.pm * 256 + wr * 64 + fr, col0 = u.pn * 256 + wc * 32 + 8 * fq;
#pragma unroll
        for (int ai = 0; ai < 2; ++ai)
#pragma unroll
            for (int m = 0; m < 4; ++m) { const size_t ro = (size_t)(row0 + ai * 128 + m * 16) * FF + col0;
#pragma unroll
                for (int bj = 0; bj < 2; ++bj) { f32x4 v0 = acc[ai][bj][m][0], v1 = acc[ai][bj][m][1];
#pragma unroll
                    for (int j = 0; j < 4; ++j) { const float r0 = fmaxf(v0[j], 0.f), r1 = fmaxf(v1[j], 0.f); v0[j] = r0 * r0; v1[j] = r1 * r1; }
                    *(u32x4*)(U + ro + bj * 128) = pack8(v0, v1); } }
    }
};

__device__ __forceinline__ void tr_load(f32x4 (&r)[8], const float* W, int K, int N, int k0, int n0, int lane) {
#pragma unroll
    for (int i = 0; i < 8; ++i) { const int k = k0 + 8 * i + (lane >> 3); r[i] = (k < K) ? __builtin_nontemporal_load((const f32x4*)(W + (size_t)k * N + n0 + (lane & 7) * 4)) : (f32x4){0.f, 0.f, 0.f, 0.f}; }
}
__device__ __forceinline__ void tr_store(const f32x4 (&r)[8], bf16_t* WT, int ldt, int dst_k0, int dst_row0, LAS float* scr, int lane) {
#pragma unroll
    for (int i = 0; i < 8; ++i) { LAS float* d = scr + (8 * i + (lane >> 3)) * 33 + (lane & 7) * 4; d[0] = r[i].x; d[1] = r[i].y; d[2] = r[i].z; d[3] = r[i].w; }
    asm volatile("s_waitcnt lgkmcnt(0)" ::: "memory");
    const int c = lane & 7;
#pragma unroll
    for (int j = 0; j < 4; ++j) { const int n = (lane >> 3) + 8 * j; const LAS float* s = scr + (8 * c) * 33 + n;
        u32x4 o; o.x = cvt_pk_bf16(s[0 * 33], s[1 * 33]); o.y = cvt_pk_bf16(s[2 * 33], s[3 * 33]); o.z = cvt_pk_bf16(s[4 * 33], s[5 * 33]); o.w = cvt_pk_bf16(s[6 * 33], s[7 * 33]);
        *(u32x4*)(WT + (size_t)(dst_row0 + n) * ldt + dst_k0 + 8 * c) = o; }
    asm volatile("s_waitcnt lgkmcnt(0)" ::: "memory");
}

__device__ __forceinline__ bf16_t* w_rg(const Params& P, int j, int which) { return (bf16_t*)(P.ws + OFF_W_RG + (size_t)j * SZ_W_RG + (which == 0 ? 0 : which == 1 ? 16 * MiB : 18 * MiB)); }
__device__ __forceinline__ bf16_t* w_rw(const Params& P, int j, int which) { return (bf16_t*)(P.ws + OFF_W_RW + (size_t)j * SZ_W_RW + (which == 0 ? 0 : which == 1 ? 27 * MiB : 30 * MiB)); }
__device__ __forceinline__ bf16_t* w_mlp(const Params& P, int i, int which) { return (bf16_t*)(P.ws + OFF_W_MLP + (size_t)i * SZ_W_MLP + (which == 0 ? 0 : 32 * MiB)); }

struct JobD { const float* W; bf16_t* WT; int K, N, ldt, nnb, nit, mode, aux; };
constexpr int NJOBS = 36;
__device__ __forceinline__ void get_job(const Params& P, int jid, JobD& d) {
    int src, Kpad; size_t soff; d.mode = 0; d.aux = 0;
    if (jid < 8) { const int i = jid >> 1;
        if (!(jid & 1)) { src = 3; soff = (size_t)i * D * FF; d.K = D; d.N = FF; d.WT = w_mlp(P, i, 0); d.ldt = D; Kpad = D; }
        else { src = 4; soff = (size_t)i * FF * D; d.K = FF; d.N = D; d.WT = w_mlp(P, i, 1); d.ldt = FF; Kpad = FF; }
    } else if (jid < 16) { const int j = (jid - 8) >> 2, q = (jid - 8) & 3;
        if (q == 0) { src = 6; soff = (size_t)j * D * 2 * D; d.K = D; d.N = 2 * D; d.WT = w_rg(P, j, 0); d.ldt = D; Kpad = D; }
        else if (q == 1) { src = 14; soff = (size_t)j * D * D; d.K = D; d.N = D; d.WT = w_rg(P, j, 2); d.ldt = D; Kpad = D; }
        else { src = (q == 2) ? 9 : 11; soff = (size_t)j * 8 * 65536; d.K = 2048; d.N = 256; d.WT = w_rg(P, j, 1); d.ldt = 256; Kpad = 2048; d.mode = 1; d.aux = (q == 2) ? 0 : 128; }
    } else { const int j = (jid - 16) / 10, q = (jid - 16) % 10; d.K = D; d.N = D; d.ldt = D; Kpad = D; d.WT = w_rw(P, j, 0);
        if (q < 3) { src = 16; soff = (size_t)(j * 3 + q) * D * D; d.aux = q * D; }
        else if (q == 3) { src = 18; soff = (size_t)j * D * 96; d.N = 96; d.aux = 6144; }
        else if (q == 4) { src = 21; soff = (size_t)j * D * 96; d.N = 96; d.aux = 6144 + 256; }
        else if (q == 5) { src = 23; soff = (size_t)j * D * 256; d.N = 256; d.aux = 6144 + 512; }
        else if (q == 6) { src = 19; soff = (size_t)j * 96 * D; d.K = 96; d.WT = w_rw(P, j, 1); d.ldt = 256; Kpad = 256; }
        else if (q == 7) { src = 22; soff = (size_t)j * 96 * D; d.K = 96; d.WT = w_rw(P, j, 1); d.ldt = 256; Kpad = 256; d.aux = 2048; }
        else if (q == 8) { src = 24; soff = (size_t)j * 256 * D; d.K = 256; d.WT = w_rw(P, j, 1); d.ldt = 256; Kpad = 256; d.aux = 4096; }
        else { src = 30; soff = (size_t)j * D * D; d.WT = w_rw(P, j, 2); }
    }
    d.W = in_ptr(P, __builtin_amdgcn_readfirstlane(src)) + soff; d.nnb = d.N / 32; d.nit = (Kpad / 64) * d.nnb;
}
__device__ __forceinline__ void convert_jobs(const Params& P, LAS unsigned char* lds, int jlo, int jhi, int gw, int NGW) {
    const int tid = otid(), lane = tid & 63, wave = __builtin_amdgcn_readfirstlane(tid >> 6);
    LAS float* scr = (LAS float*)(lds + wave * 16384);
    int jid = jlo, it = gw; JobD cj; get_job(P, jid, cj);
    while (it >= cj.nit) { it -= cj.nit; if (++jid >= jhi) return; get_job(P, jid, cj); }
    f32x4 r[8]; tr_load(r, cj.W, cj.K, cj.N, (it / cj.nnb) * 64, (it % cj.nnb) * 32, lane);
    for (;;) {
        int njid = jid, nit_ = it + NGW; JobD nj = cj; bool have = true;
        while (nit_ >= nj.nit) { nit_ -= nj.nit; if (++njid >= jhi) { have = false; break; } get_job(P, njid, nj); }
        f32x4 rn[8];
        if (have) tr_load(rn, nj.W, nj.K, nj.N, (nit_ / nj.nnb) * 64, (nit_ % nj.nnb) * 32, lane);
        else {
#pragma unroll
            for (int q = 0; q < 8; ++q) rn[q] = (f32x4){0.f, 0.f, 0.f, 0.f};
        }
        const int k0 = (it / cj.nnb) * 64, n0 = (it % cj.nnb) * 32;
        const int drow = (cj.mode == 1) ? (((k0 >> 8) * 2 + (n0 >> 7)) * 256 + cj.aux + (n0 & 127)) : (cj.aux + n0);
        const int dk0 = (cj.mode == 1) ? (k0 & 255) : k0;
        tr_store(r, cj.WT, cj.ldt, dk0, drow, scr, lane);
        if (!have) break;
#pragma unroll
        for (int q = 0; q < 8; ++q) r[q] = rn[q];
        jid = njid; it = nit_; cj = nj;
    }
}
__device__ __forceinline__ void phase_convert(const Params& P, LAS unsigned char* lds) {
    const int tid = otid(), bid = obid(), wave = __builtin_amdgcn_readfirstlane(tid >> 6);
    const int gw = bid * 8 + wave, NGW = gridDim.x * 8;
    for (int j = 0; j < 2; ++j) {
        u32x4* z0 = (u32x4*)(w_rw(P, j, 0) + (size_t)(6144 + 96) * D); u32x4* z1 = (u32x4*)(w_rw(P, j, 0) + (size_t)(6144 + 256 + 96) * D);
        for (int i = bid * 512 + tid; i < 40960; i += gridDim.x * 512) { z0[i] = (u32x4){0u, 0u, 0u, 0u}; z1[i] = (u32x4){0u, 0u, 0u, 0u}; }
    }
    convert_jobs(P, lds, 0, 4, gw, NGW);
    convert_jobs(P, lds, 8, NJOBS, gw, NGW);
}

template <bool F32OUT> __device__ __forceinline__ void phase_norm(const float* __restrict__ src, const float* __restrict__ g, bf16_t* __restrict__ dstb, float* __restrict__ dstf) {
    const int tid = otid(), lane = tid & 63, gw = obid() * 8 + (tid >> 6), NGW = gridDim.x * 8;
    for (int row = gw; row < T; row += NGW) {
        const f32x4* xr = (const f32x4*)(src + (size_t)row * D) + 2 * lane;
        f32x4 v[8]; float s = 0.f;
#pragma unroll
        for (int j = 0; j < 4; ++j) { v[2 * j] = xr[128 * j]; v[2 * j + 1] = xr[128 * j + 1];
            s += (v[2 * j].x * v[2 * j].x + v[2 * j].y * v[2 * j].y) + (v[2 * j].z * v[2 * j].z + v[2 * j].w * v[2 * j].w);
            s += (v[2 * j + 1].x * v[2 * j + 1].x + v[2 * j + 1].y * v[2 * j + 1].y) + (v[2 * j + 1].z * v[2 * j + 1].z + v[2 * j + 1].w * v[2 * j + 1].w); }
        const float sc = 1.f / sqrtf(wave_sum(s) * (1.f / D) + 1e-6f);
#pragma unroll
        for (int j = 0; j < 4; ++j) { const int i4 = 128 * j + 2 * lane; const f32x4 o0 = v[2 * j] * sc * ((const f32x4*)g)[i4], o1 = v[2 * j + 1] * sc * ((const f32x4*)g)[i4 + 1];
            if (F32OUT) { __builtin_nontemporal_store(o0, (f32x4*)(dstf + (size_t)row * D) + i4); __builtin_nontemporal_store(o1, (f32x4*)(dstf + (size_t)row * D) + i4 + 1); }
            else ((u32x4*)(dstb + (size_t)row * D))[64 * j + lane] = pack8(o0, o1); }
    }
}

__device__ __forceinline__ void phase_mix(const float* __restrict__ src, const float* __restrict__ g, const float* __restrict__ mu, bf16_t* __restrict__ xm) {
    const int tid = otid(), lane = tid & 63, gw = obid() * 8 + (tid >> 6), NGW = gridDim.x * 8;
    for (int row = gw; row < T; row += NGW) {
        const bool hasp = (row % S) != 0;
        const f32x4* xr = (const f32x4*)(src + (size_t)row * D) + lane; const f32x4* pr = xr - (D / 4);
        float s = 0.f, sp = 0.f;
#pragma unroll
        for (int j = 0; j < 8; ++j) { const f32x4 v = xr[64 * j]; s += (v.x * v.x + v.y * v.y) + (v.z * v.z + v.w * v.w);
            const f32x4 p = hasp ? pr[64 * j] : (f32x4){0.f, 0.f, 0.f, 0.f}; sp += (p.x * p.x + p.y * p.y) + (p.z * p.z + p.w * p.w); }
        const float sc = 1.f / sqrtf(wave_sum(s) * (1.f / D) + 1e-6f), scp = 1.f / sqrtf(wave_sum(sp) * (1.f / D) + 1e-6f);
        const f32x4* x2 = (const f32x4*)(src + (size_t)row * D) + 2 * lane; const f32x4* p2 = x2 - (D / 4);
#pragma unroll 1
        for (int j = 0; j < 4; ++j) { const int i4 = 128 * j + 2 * lane; const f32x4 z4 = {0.f, 0.f, 0.f, 0.f};
            const f32x4 v0 = x2[128 * j], v1 = x2[128 * j + 1], q0 = hasp ? p2[128 * j] : z4, q1 = hasp ? p2[128 * j + 1] : z4;
            const f32x4 g0 = ((const f32x4*)g)[i4], g1 = ((const f32x4*)g)[i4 + 1];
            const f32x4 hn0 = v0 * sc * g0, hn1 = v1 * sc * g1, xx0 = q0 * scp * g0 - hn0, xx1 = q1 * scp * g1 - hn1;
#pragma unroll
            for (int q = 0; q < 6; ++q) { const f32x4 m0 = ((const f32x4*)(mu + q * D))[i4], m1 = ((const f32x4*)(mu + q * D))[i4 + 1];
                ((u32x4*)(xm + (size_t)q * TD + (size_t)row * D))[64 * j + lane] = pack8(hn0 + xx0 * m0, hn1 + xx1 * m1); } }
    }
}

__device__ __forceinline__ void phase_conv(const bf16_t* __restrict__ rec, const float* __restrict__ cw, const float* __restrict__ cb, bf16_t* __restrict__ cvb) {
    const int n8 = T * (D / 8);
    for (int idx = obid() * 512 + otid(); idx < n8; idx += gridDim.x * 512) {
        const int row = idx / (D / 8), c8 = idx % (D / 8), t = row % S;
        f32x4 a0 = ((const f32x4*)cb)[2 * c8], a1 = ((const f32x4*)cb)[2 * c8 + 1];
#pragma unroll
        for (int k = 0; k < 4; ++k) { const int dt = 3 - k; if (t - dt >= 0) { f32x4 r0, r1; unpack8(((const u32x4*)(rec + (size_t)(row - dt) * D))[c8], r0, r1);
            a0 += ((const f32x4*)(cw + k * D))[2 * c8] * r0; a1 += ((const f32x4*)(cw + k * D))[2 * c8 + 1] * r1; } }
        ((u32x4*)cvb)[idx] = pack8(a0, a1);
    }
}

__device__ __forceinline__ void phase_scan1(const bf16_t* __restrict__ at, const bf16_t* __restrict__ bt, float* __restrict__ agga, float* __restrict__ aggh) {
    const int tid = otid();
    for (int item = obid(); item < 256; item += gridDim.x) {
        const int b = item >> 7, chunk = (item >> 1) & 63, half = item & 1, c = half * 1024 + 2 * tid;
        const size_t r0 = (size_t)(b * S + chunk * 64) * D + c;
        f32x2 hh = {0.f, 0.f}, pp = {1.f, 1.f};
#pragma unroll 16
        for (int t = 0; t < 64; ++t) { const size_t o = r0 + (size_t)t * D; const unsigned au = *(const unsigned*)(at + o), bu = *(const unsigned*)(bt + o);
            const f32x2 a2 = {__expf(__uint_as_float(au << 16)), __expf(__uint_as_float(au & 0xffff0000u))}, b2 = {__uint_as_float(bu << 16), __uint_as_float(bu & 0xffff0000u)};
            hh = a2 * hh + b2; pp = pp * a2; }
        const size_t ao = (size_t)(b * 64 + chunk) * D + c; *(f32x2*)(agga + ao) = pp; *(f32x2*)(aggh + ao) = hh;
    }
}
__device__ __forceinline__ void phase_scan2(const bf16_t* __restrict__ at, const bf16_t* __restrict__ bt, const float* __restrict__ agga, const float* __restrict__ aggh, const bf16_t* __restrict__ gate, bf16_t* __restrict__ acta) {
    const int tid = otid();
    for (int item = obid(); item < 256; item += gridDim.x) {
        const int b = item >> 7, chunk = (item >> 1) & 63, half = item & 1, c = half * 1024 + 2 * tid;
        f32x2 hh = {0.f, 0.f};
        for (int k = 0; k < chunk; ++k) { const size_t ao = (size_t)(b * 64 + k) * D + c; hh = *(const f32x2*)(agga + ao) * hh + *(const f32x2*)(aggh + ao); }
        const size_t r0 = (size_t)(b * S + chunk * 64) * D + c;
#pragma unroll 16
        for (int t = 0; t < 64; ++t) { const size_t o = r0 + (size_t)t * D; const unsigned au = __builtin_nontemporal_load((const unsigned*)(at + o)), bu = __builtin_nontemporal_load((const unsigned*)(bt + o)), gu = __builtin_nontemporal_load((const unsigned*)(gate + o));
            const f32x2 a2 = {__expf(__uint_as_float(au << 16)), __expf(__uint_as_float(au & 0xffff0000u))}, b2 = {__uint_as_float(bu << 16), __uint_as_float(bu & 0xffff0000u)};
            hh = a2 * hh + b2;
            *(unsigned*)(acta + o) = cvt_pk_bf16(hh.x * __uint_as_float(gu << 16), hh.y * __uint_as_float(gu & 0xffff0000u)); }
    }
}

__device__ __forceinline__ void phase_recur(const bf16_t* Rg, const bf16_t* Kg, const bf16_t* Vg, const float* DECg, const float* AAg,
                                            const float* k_k, const float* k_a, const float* r_k, float* BON, float* Yg, LAS unsigned char* lds) {
    constexpr int CH = 32, NCH = S / CH;
    constexpr int OFF_V_ = 5 * CH * 64, OFF_YP = OFF_V_ + CH * 16, BUF_F = OFF_YP + CH * 256;
    LAS float* L = (LAS float*)lds;
    const int tid = otid(), wave = tid >> 6, lane = tid & 63;
    for (int it0 = obid(); it0 < 256; it0 += gridDim.x) {
        const int item = (gridDim.x == 256) ? ((it0 & 7) * 32 + (it0 >> 3)) : it0;
        const int b = item >> 7, hh = (item >> 2) & 31, q = item & 3;
        const size_t rowbase = (size_t)b * S;
        const int colh = hh * 64;
        const int ltid = tid - 256, lt = (ltid >> 4) & 15, lj0 = (ltid & 15) * 4, vt = (ltid >> 2) & 31, vi = (ltid & 3) * 4;
        const bool vldr = ltid < 128;
        __syncthreads();
        if (wave >= 4) {
            const f32x4 kkc = *(const f32x4*)(k_k + colh + lj0), kac = *(const f32x4*)(k_a + colh + lj0), rkc = *(const f32x4*)(r_k + colh + lj0);
            f32x4 ga0A = {0, 0, 0, 0}, ga1A = {0, 0, 0, 0}, gd0A = {0, 0, 0, 0}, gd1A = {0, 0, 0, 0}; u32x2 gk0A = {0, 0}, gk1A = {0, 0}, gr0A = {0, 0}, gr1A = {0, 0}, gvrA = {0, 0};
            f32x4 ga0B = {0, 0, 0, 0}, ga1B = {0, 0, 0, 0}, gd0B = {0, 0, 0, 0}, gd1B = {0, 0, 0, 0}; u32x2 gk0B = {0, 0}, gk1B = {0, 0}, gr0B = {0, 0}, gr1B = {0, 0}, gvrB = {0, 0};
#define RC_GLOAD(X, ch) do { if ((ch) < NCH) { const size_t go = (rowbase + (size_t)(ch) * CH + lt) * D + colh + lj0, go1 = go + (size_t)16 * D; \
                gk0##X = *(const u32x2*)(Kg + go); gr0##X = *(const u32x2*)(Rg + go); ga0##X = *(const f32x4*)(AAg + go); gd0##X = *(const f32x4*)(DECg + go); \
                gk1##X = *(const u32x2*)(Kg + go1); gr1##X = *(const u32x2*)(Rg + go1); ga1##X = *(const f32x4*)(AAg + go1); gd1##X = *(const f32x4*)(DECg + go1); \
                if (vldr) gvr##X = *(const u32x2*)(Vg + (rowbase + (size_t)(ch) * CH + vt) * D + colh + q * 16 + vi); } } while (0)
#define RC_LW1(B, kraw, rraw, av, dv, tt, chk) do { const f32x4 kf = unpack4(kraw), rf = unpack4(rraw); f32x4 nn = kf * kkc; \
                const float ss = row16_allsum((nn.x * nn.x + nn.y * nn.y) + (nn.z * nn.z + nn.w * nn.w)); \
                const float inv = __builtin_amdgcn_rcpf(fmaxf(__builtin_amdgcn_sqrtf(ss), 1e-12f)); nn = nn * inv; \
                const f32x4 one = {1.f, 1.f, 1.f, 1.f}; const int lo = (tt) * 64 + lj0; const f32x4 km = kf * (one + (av - one) * kac), bt_ = rf * km * rkc; \
                const float bs = row16_allsum((bt_.x + bt_.y) + (bt_.z + bt_.w)); \
                if (q == 0 && (ltid & 15) == 0) BON[(rowbase + (size_t)(chk) * CH + (tt)) * 32 + hh] = bs;     \
                *(LAS f32x4*)(B + 0 * CH * 64 + lo) = dv; *(LAS f32x4*)(B + 1 * CH * 64 + lo) = nn; *(LAS f32x4*)(B + 2 * CH * 64 + lo) = nn * av; \
                *(LAS f32x4*)(B + 3 * CH * 64 + lo) = km; *(LAS f32x4*)(B + 4 * CH * 64 + lo) = rf; } while (0)
#define RC_LWRITE(X, buf, chk) do { LAS float* B = L + (buf) * BUF_F; RC_LW1(B, gk0##X, gr0##X, ga0##X, gd0##X, lt, chk); RC_LW1(B, gk1##X, gr1##X, ga1##X, gd1##X, lt + 16, chk); \
                if (vldr) *(LAS f32x4*)(B + OFF_V_ + vt * 16 + vi) = unpack4(gvr##X); } while (0)
#define RC_FLUSH(ch, buf) do { if (wave >= 6) { const LAS float* Bp = L + (buf) * BUF_F + OFF_YP + (wave - 6) * 16 * 256 + lane * 4; \
                float* yo = Yg + (rowbase + (size_t)(ch) * CH + (wave - 6) * 16) * D + colh + q * 16 + (lane >> 2); \
                _Pragma("unroll") for (int _i = 0; _i < 16; ++_i) { const f32x4 p4 = *(const LAS f32x4*)(Bp + _i * 256); float sq = (p4.x + p4.y) + (p4.z + p4.w); \
                    sq += dpp_f<0xB1>(sq); sq += dpp_f<0x4E>(sq); if ((lane & 3) == 0) yo[(size_t)_i * D] = sq; } } } while (0)
            RC_GLOAD(A, 0); RC_LWRITE(A, 0, 0); RC_GLOAD(A, 1); RC_GLOAD(B, 2);
            __syncthreads();
            for (int ch = 0; ch < NCH; ch += 2) {
                RC_LWRITE(A, 1, ch + 1); RC_GLOAD(A, ch + 3);
                if (ch >= 1) RC_FLUSH(ch - 1, 1);
                __syncthreads();
                if (ch + 2 < NCH) { RC_LWRITE(B, 0, ch + 2); RC_GLOAD(B, ch + 4); }
                RC_FLUSH(ch, 0);
                __syncthreads();
            }
            RC_FLUSH(NCH - 1, 1);
#undef RC_GLOAD
#undef RC_LW1
#undef RC_LWRITE
#undef RC_FLUSH
        } else {
            __syncthreads();
            const int rl = wave * 4 + (lane >> 4), js = lane & 15;
            f32x2 sa = {0.f, 0.f}, sb = {0.f, 0.f};
            for (int ch = 0; ch < NCH; ++ch) {
                LAS float* B = L + (ch & 1) * BUF_F;
                const LAS float* pj = B + js * 4; const LAS float* pv = B + OFF_V_ + rl; LAS float* py = B + OFF_YP + rl * 16 + js;
                f32x4 w4 = *(const LAS f32x4*)(pj + 0 * CH * 64), k4 = *(const LAS f32x4*)(pj + 1 * CH * 64), b4 = *(const LAS f32x4*)(pj + 2 * CH * 64);
                f32x4 m4 = *(const LAS f32x4*)(pj + 3 * CH * 64), r4 = *(const LAS f32x4*)(pj + 4 * CH * 64); float v = pv[0];
#pragma unroll
                for (int t = 0; t < CH; ++t) {
                    const int tn = (t + 1 < CH) ? t + 1 : t;
                    const f32x4 w4n = *(const LAS f32x4*)(pj + 0 * CH * 64 + tn * 64), k4n = *(const LAS f32x4*)(pj + 1 * CH * 64 + tn * 64), b4n = *(const LAS f32x4*)(pj + 2 * CH * 64 + tn * 64);
                    const f32x4 m4n = *(const LAS f32x4*)(pj + 3 * CH * 64 + tn * 64), r4n = *(const LAS f32x4*)(pj + 4 * CH * 64 + tn * 64); const float vn = pv[tn * 16];
                    const f32x2 pk = sa * k4.xy + sb * k4.zw;
                    const float p = row16_allsum(pk.x + pk.y);
                    const f32x2 pp = {p, p}, vv = {v, v};
                    sa = sa * w4.xy + (vv * m4.xy - pp * b4.xy);
                    sb = sb * w4.zw + (vv * m4.zw - pp * b4.zw);
                    const f32x2 yk = sa * r4.xy + sb * r4.zw;
                    py[t * 256] = yk.x + yk.y;
                    w4 = w4n; k4 = k4n; b4 = b4n; m4 = m4n; r4 = r4n; v = vn;
                }
                __syncthreads();
            }
        }
    }
}

__device__ __forceinline__ float oct_allsum(float x) {
    x += dpp_f<0x141>(x); x += dpp_f<0x4E>(x); x += dpp_f<0xB1>(x); return x;
}
__device__ __forceinline__ void phase_gn(const float* __restrict__ Yg, const bf16_t* __restrict__ Vg, const bf16_t* __restrict__ GGg, const float* __restrict__ BON,
                                         const float* __restrict__ ln_g, const float* __restrict__ ln_b, bf16_t* __restrict__ acta) {
    const int tid = otid(), lane = tid & 63, gw = obid() * 8 + (tid >> 6), NGW = gridDim.x * 8;
    for (int row = gw; row < T; row += NGW) {
        const size_t ro = (size_t)row * D;
#pragma unroll 2
        for (int j = 0; j < 4; ++j) { const int c = (64 * j + lane) * 8; const size_t o = ro + c;
            const f32x4 y0 = __builtin_nontemporal_load((const f32x4*)(Yg + o)), y1 = __builtin_nontemporal_load((const f32x4*)(Yg + o + 4));
            f32x4 v0, v1, g0, g1;
            unpack8(__builtin_nontemporal_load((const u32x4*)(Vg + o)), v0, v1); unpack8(__builtin_nontemporal_load((const u32x4*)(GGg + o)), g0, g1);
            const float sb = BON[(size_t)row * 32 + (c >> 6)];
            const f32x4 lg0 = *(const f32x4*)(ln_g + c), lg1 = *(const f32x4*)(ln_g + c + 4), lb0 = *(const f32x4*)(ln_b + c), lb1 = *(const f32x4*)(ln_b + c + 4);
            float sm = ((y0.x + y0.y) + (y0.z + y0.w)) + ((y1.x + y1.y) + (y1.z + y1.w));
            sm = oct_allsum(sm);
            const float mean = sm * (1.f / 64.f); const f32x4 d0 = y0 - mean, d1 = y1 - mean;
            float sv = ((d0.x * d0.x + d0.y * d0.y) + (d0.z * d0.z + d0.w * d0.w)) + ((d1.x * d1.x + d1.y * d1.y) + (d1.z * d1.z + d1.w * d1.w)); sv = oct_allsum(sv);
            const float rstd = 1.f / sqrtf(sv * (1.f / 64.f) + 64e-5f);
            *(u32x4*)(acta + o) = pack8((d0 * rstd * lg0 + lb0 + v0 * sb) * g0, (d1 * rstd * lg1 + lb1 + v1 * sb) * g1); }
    }
}

__device__ __forceinline__ void run_phase(const Params& P, int ph, LAS unsigned char* lds) {
    unsigned char* ws = P.ws;
    float* H0 = (float*)(ws + OFF_H); float* H1 = (float*)(ws + OFF_H2); bf16_t* ACTA = (bf16_t*)(ws + OFF_ACTA);
    const int G = gridDim.x, c = obid();
    if (ph == 0) { if constexpr (KEN(20)) { phase_convert(P, lds); phase_norm<false>(in_ptr(P, 0), in_ptr(P, 1), ACTA, nullptr); } return; }
    if (ph == 39) { if constexpr (KEN(21)) phase_norm<true>(H1, in_ptr(P, 5), nullptr, P.out); return; }
    const int p = ph - 1, pair = p / 19, r = p % 19;
    const bool is_rg = r < 10; const int layer = 2 * pair + (is_rg ? 0 : 1), sub = is_rg ? r : r - 10, j = pair;
    const float* hsrc = (layer == 0) ? in_ptr(P, 0) : H1;
    int kind;
    if (is_rg) kind = sub; else kind = (sub < 5) ? 10 + sub : sub + 1;
    switch (kind) {
    case 0: if constexpr (KEN(0)) phase_norm<false>(hsrc, in_ptr(P, 1) + (size_t)layer * D, ACTA, nullptr); break;
    case 7: if constexpr (KEN(0)) phase_norm<false>(H0, in_ptr(P, 2) + (size_t)layer * D, ACTA, nullptr); break;
    case 1: if constexpr (KEN(1)) { pg8::Gemm g{ACTA, w_rg(P, j, 0), T, 2 * D, D, D, D}; pg8::Order<0> So; So.init(T, 2 * D, G, c);
        EpiInProj E{(bf16_t*)(ws + OFF_GATE), (bf16_t*)(ws + OFF_REC)}; pg8::gemm_phase(lds, g, So, E); break; }
    case 2: if constexpr (KEN(2)) phase_conv((const bf16_t*)(ws + OFF_REC), in_ptr(P, 7) + (size_t)j * 4 * D, in_ptr(P, 8) + (size_t)j * D, (bf16_t*)(ws + OFF_CVB)); break;
    case 3: if constexpr (KEN(3)) { pg8::Gemm g{(const bf16_t*)(ws + OFF_CVB), w_rg(P, j, 1), T, 2 * D, 256, D, 256}; pg8::Order<1> So; So.init(T, 2 * D, G, c);
        EpiGates E{in_ptr(P, 10) + (size_t)j * D, in_ptr(P, 12) + (size_t)j * D, in_ptr(P, 13) + (size_t)j * D, (const bf16_t*)(ws + OFF_CVB), (bf16_t*)(ws + OFF_AT), (bf16_t*)(ws + OFF_BT)};
        pg8::gemm_phase(lds, g, So, E); break; }
    case 4: if constexpr (KEN(4)) phase_scan1((const bf16_t*)(ws + OFF_AT), (const bf16_t*)(ws + OFF_BT), (float*)(ws + OFF_AGGA), (float*)(ws + OFF_AGGH)); break;
    case 5: if constexpr (KEN(5)) phase_scan2((const bf16_t*)(ws + OFF_AT), (const bf16_t*)(ws + OFF_BT), (const float*)(ws + OFF_AGGA), (const float*)(ws + OFF_AGGH), (const bf16_t*)(ws + OFF_GATE), ACTA); break;
    case 6: case 9: if constexpr (KEN(6)) { const bool down = (kind == 9);
        const bf16_t* A = down ? (const bf16_t*)(ws + OFF_U) : ACTA; const bf16_t* Bt = down ? w_mlp(P, layer, 1) : (is_rg ? w_rg(P, j, 2) : w_rw(P, j, 2));
        const int K = down ? FF : D; pg8::Gemm g{A, Bt, T, D, K, K, K}; pg8::Order<0> So; So.init(T, D, G, c);
        EpiResidual E{down ? (const float*)H0 : hsrc, down ? H1 : H0}; pg8::gemm_phase(lds, g, So, E); break; }
    case 8: if constexpr (KEN(8)) { pg8::Gemm g{ACTA, w_mlp(P, layer, 0), T, FF, D, D, D}; pg8::Order<0> So; So.init(T, FF, G, c);
        EpiUp E{(bf16_t*)(ws + OFF_U)}; pg8::gemm_phase(lds, g, So, E); break; }
    case 10: if constexpr (KEN(10)) phase_mix(hsrc, in_ptr(P, 1) + (size_t)layer * D, in_ptr(P, 15) + (size_t)j * 6 * D, (bf16_t*)(ws + OFF_XM)); break;
    case 11: if constexpr (KEN(11)) { pg8::Gemm g{(const bf16_t*)(ws + OFF_XM), w_rw(P, j, 0), T, 6912, D, D, D}; pg8::Order<2> So; So.init(T, 6912, G, c);
        EpiRKV E{ws + OFF_R, (bf16_t*)(ws + OFF_LORA)}; pg8::gemm_phase(lds, g, So, E);
        { const int nfull = 864 % G; if (nfull != 0 && c >= nfull) { const int wv = __builtin_amdgcn_readfirstlane(otid() >> 6); convert_jobs(P, lds, 4 + 2 * j, 6 + 2 * j, (c - nfull) * 8 + wv, (G - nfull) * 8); }
          else if (nfull == 0) { const int wv = __builtin_amdgcn_readfirstlane(otid() >> 6); convert_jobs(P, lds, 4 + 2 * j, 6 + 2 * j, c * 8 + wv, G * 8); } }
        break; }
    case 12: if constexpr (KEN(12)) { pg8::Gemm g{(const bf16_t*)(ws + OFF_LORA), w_rw(P, j, 1), T, 6144, 256, 256, 256}; pg8::Order<3> So; So.init(T, 6144, G, c);
        EpiLoraUp E{in_ptr(P, 17) + (size_t)j * D, in_ptr(P, 20) + (size_t)j * D, (float*)(ws + OFF_DEC)}; pg8::gemm_phase(lds, g, So, E); break; }
    case 13: if constexpr (KEN(13)) phase_recur((const bf16_t*)(ws + OFF_R), (const bf16_t*)(ws + OFF_K), (const bf16_t*)(ws + OFF_V), (const float*)(ws + OFF_DEC), (const float*)(ws + OFF_AA),
                         in_ptr(P, 25) + (size_t)j * D, in_ptr(P, 26) + (size_t)j * D, in_ptr(P, 27) + (size_t)j * D, (float*)(ws + OFF_BON), (float*)(ws + OFF_YREC), lds); break;
    case 14: if constexpr (KEN(14)) phase_gn((const float*)(ws + OFF_YREC), (const bf16_t*)(ws + OFF_V), (const bf16_t*)(ws + OFF_GG), (const float*)(ws + OFF_BON),
                      in_ptr(P, 28) + (size_t)j * D, in_ptr(P, 29) + (size_t)j * D, ACTA); break;
    default: break;
    }
}

#define XB_TMO      128
#define XB_XCNT(j)  (256  + 64 * (j))
#define XB_XSUB(j)  (1280 + 64 * (j))
#define XB_XGEN(j)  (2304 + 64 * (j))
#define XB_TOP      3328
#define XB_TOPGEN   3392
#define XCD_BAR_WORDS 3456
#define XB_SPIN_CAP (1u << 20)
__device__ __forceinline__ unsigned xb_ld(unsigned* p)              { return __hip_atomic_load(p, __ATOMIC_RELAXED, __HIP_MEMORY_SCOPE_AGENT); }
__device__ __forceinline__ unsigned xb_add(unsigned* p, unsigned v) { return __hip_atomic_fetch_add(p, v, __ATOMIC_RELAXED, __HIP_MEMORY_SCOPE_AGENT); }
__device__ __forceinline__ unsigned xb_xcc_id() { return (unsigned)__builtin_amdgcn_s_getreg((3 << 11) | 20) & 0xFu; }
#define XB_SPIN(cond, bar) do { unsigned _sp = 0; while (cond) { __builtin_amdgcn_s_sleep(1); \
    if ((++_sp & 255u) == 0u) { if (xb_ld(&(bar)[XB_TMO])) break; if (_sp > XB_SPIN_CAP) { atomicAdd(&(bar)[XB_TMO], 1u); break; } } } } while (0)
struct XcdBarrier { unsigned* bar; unsigned x; volatile LAS unsigned* st; };
__device__ __forceinline__ XcdBarrier xcd_barrier_post(unsigned* bar, volatile LAS unsigned* st) {
    XcdBarrier b; b.bar = bar; b.x = xb_xcc_id(); b.st = st;
    if (threadIdx.x == 0) (void)xb_add(&bar[XB_XCNT(b.x)], 1u);
    return b;
}
__device__ __forceinline__ void xcd_barrier_complete(unsigned* bar, unsigned x, unsigned& nloc, unsigned& nx) {
    const unsigned G = gridDim.x * gridDim.y * gridDim.z;
    unsigned sum, cnt, mine, sp = 0u;
    for (;;) {
        sum = 0u; cnt = 0u; mine = 0u;
#pragma unroll
        for (unsigned j = 0; j < 16; ++j) { const unsigned c = xb_ld(&bar[XB_XCNT(j)]); sum += c; cnt += (c > 0u) ? 1u : 0u; mine = (j == x) ? c : mine; }
        if (sum == G) break;
        __builtin_amdgcn_s_sleep(1);
        if ((++sp & 255u) == 0u) { if (xb_ld(&bar[XB_TMO])) break; if (sp > XB_SPIN_CAP) { atomicAdd(&bar[XB_TMO], 1u); break; } }
    }
    nloc = mine > 0u ? mine : 1u; nx = cnt > 0u ? cnt : 1u;
}
__device__ __forceinline__ void xcd_barrier(const XcdBarrier& b) {
    asm volatile("s_waitcnt vmcnt(0)" ::: "memory");
    __syncthreads();
    if (threadIdx.x == 0) {
        unsigned* bar = b.bar;
        __builtin_amdgcn_s_waitcnt(0);
        unsigned nloc = b.st[0], nx = b.st[1];
        if (nloc == 0u) { xcd_barrier_complete(bar, b.x, nloc, nx); b.st[0] = nloc; b.st[1] = nx; }
        const unsigned old = xb_add(&bar[XB_XSUB(b.x)], 1u);
        const unsigned gen = old / nloc;
        if (old + 1u == (gen + 1u) * nloc) {
            __builtin_amdgcn_fence(__ATOMIC_RELEASE, "agent");
            asm volatile("s_waitcnt vmcnt(0)" ::: "memory");
            const unsigned og = xb_add(&bar[XB_TOP], 1u);
            const unsigned tg = og / nx;
            if (og + 1u == (tg + 1u) * nx) xb_add(&bar[XB_TOPGEN], 1u);
            else XB_SPIN(xb_ld(&bar[XB_TOPGEN]) == tg, bar);
            __builtin_amdgcn_fence(__ATOMIC_ACQUIRE, "agent");
            xb_add(&bar[XB_XGEN(b.x)], 1u);
            asm volatile("s_waitcnt vmcnt(0)" ::: "memory");
        } else {
            XB_SPIN(xb_ld(&bar[XB_XGEN(b.x)]) == gen, bar);
            __builtin_amdgcn_fence(__ATOMIC_ACQUIRE, "agent");
            asm volatile("s_waitcnt vmcnt(0)" ::: "memory");
        }
    }
    __syncthreads();
}

constexpr int N_PHASES = 40;

__global__ void __launch_bounds__(512, 2) mega(Params P) {
    extern __shared__ __attribute__((aligned(16))) unsigned char shm[];
    LAS unsigned char* lds = (LAS unsigned char*)shm;
    cg::grid_group grid = cg::this_grid();
    volatile LAS unsigned* st = (volatile LAS unsigned*)(lds + LDS_ST_OFF);
    if (threadIdx.x == 0) { st[0] = 0u; st[1] = 0u; }
    __syncthreads();
    const XcdBarrier xb = xcd_barrier_post((unsigned*)(P.ws + OFF_BAR), st);
    bool first_seam = true;
    for (int ph = P.ph_lo; ph < P.ph_hi; ++ph) {
        if (ph == 1) continue;
        int nrep = 1;
        if (REPMASK != 0u) {
            int kind; if (ph == 0) kind = 20; else if (ph == 39) kind = 21; else { const int r = (ph - 1) % 19; kind = r < 10 ? r : (r - 10 < 5 ? r : r - 9); }
            if ((REPMASK >> kind) & 1u) nrep = 2;
        }
        for (int rep = 0; rep < nrep; ++rep) {
            if (ph > P.ph_lo || rep > 0) {
                if (first_seam) { grid.sync(); first_seam = false; }
                else xcd_barrier(xb);
            }
            run_phase(P, ph, lds);
        }
    }
}

extern "C" void kernel_launch(void* const* d_in, const int* in_sizes, int n_in, void* d_out, int out_size, void* d_ws, size_t ws_size, hipStream_t stream) {
    static int grid = 0;
    if (grid == 0) {
        if (n_in != 31 || in_sizes[0] != T * D || out_size != T * D || ws_size < WS_END) {
            fprintf(stderr, "kernel_launch: unexpected shapes: n_in %d in0 %d out %d ws %zu (need %zu)\n", n_in, n_in > 0 ? in_sizes[0] : -1, out_size, ws_size, (size_t)WS_END); grid = -1; return; }
        int dev = 0, cus = 0, per_cu = 0;
        hipGetDevice(&dev); hipDeviceGetAttribute(&cus, hipDeviceAttributeMultiprocessorCount, dev);
        if (hipFuncSetAttribute((const void*)mega, hipFuncAttributeMaxDynamicSharedMemorySize, LDS_BYTES) != hipSuccess) { fprintf(stderr, "kernel_launch: hipFuncSetAttribute failed\n"); grid = -1; return; }
        if (hipOccupancyMaxActiveBlocksPerMultiprocessor(&per_cu, (const void*)mega, 512, LDS_BYTES) != hipSuccess || per_cu < 1) { fprintf(stderr, "kernel_launch: occupancy query says %d\n", per_cu); per_cu = 1; }
        (void)hipGetLastError();
        grid = cus * per_cu;
    }
    if (grid < 0) return;
    Params p{};
    for (int i = 0; i < 31; ++i) p.in[i] = (const float*)d_in[i];
    p.out = (float*)d_out; p.ws = (unsigned char*)d_ws;
    if (hipMemsetAsync((char*)d_ws + OFF_BAR, 0, XCD_BAR_WORDS * 4, stream) != hipSuccess) { fprintf(stderr, "kernel_launch: memset of the barrier words failed\n"); return; }
#if N_LAUNCH_PER_PHASE
    for (int ph = 0; ph < N_PHASES; ++ph) { p.ph_lo = ph; p.ph_hi = ph + 1; hipLaunchKernelGGL(mega, dim3(grid), dim3(512), LDS_BYTES, stream, p); }
#else
    p.ph_lo = 0; p.ph_hi = N_PHASES;
    void* args[] = {&p};
    hipError_t e = hipLaunchCooperativeKernel((const void*)mega, dim3(grid), dim3(512), args, LDS_BYTES, stream);
    if (e != hipSuccess) fprintf(stderr, "cooperative launch failed: %s (grid %d)\n", hipGetErrorString(e), grid);
#endif
}
```

```cpp
#include <hip/hip_runtime.h>
#include <hip/hip_cooperative_groups.h>
#include <cstdio>
#include <cstdint>
namespace cg = cooperative_groups;

#ifndef N_LAUNCH_PER_PHASE
#define N_LAUNCH_PER_PHASE 0
#endif

#ifndef KMASK
#define KMASK 0xffffffu
#endif
#define KEN(n) (((KMASK) >> (n)) & 1u)
#ifndef REPMASK
#define REPMASK 0u
#endif
#define LAS __attribute__((address_space(3)))
typedef unsigned short bf16_t;
typedef short bf16x8 __attribute__((ext_vector_type(8)));
typedef float f32x4 __attribute__((ext_vector_type(4)));
typedef float f32x2 __attribute__((ext_vector_type(2)));
typedef unsigned u32x2 __attribute__((ext_vector_type(2)));
typedef unsigned u32x4 __attribute__((ext_vector_type(4)));

constexpr int T = 8192, D = 2048, S = 4096, FF = 8192;
constexpr size_t MiB = 1ull << 20;
constexpr size_t TD = (size_t)T * D;
constexpr size_t SZ_W_RG = 26 * MiB;
constexpr size_t SZ_W_RW = 38 * MiB;
constexpr size_t SZ_W_MLP = 64 * MiB;
constexpr size_t OFF_W_RG = 0;
constexpr size_t OFF_W_RW = OFF_W_RG + 2 * SZ_W_RG;
constexpr size_t OFF_W_MLP = OFF_W_RW + 2 * SZ_W_RW;
constexpr size_t OFF_H = OFF_W_MLP + 4 * SZ_W_MLP;
constexpr size_t OFF_ACTA = OFF_H + 64 * MiB;
constexpr size_t OFF_X = OFF_ACTA + 32 * MiB;
constexpr size_t OFF_XM = OFF_X;
constexpr size_t OFF_DEC = OFF_X, OFF_AA = OFF_X + 64 * MiB, OFF_GG = OFF_X + 128 * MiB;
constexpr size_t OFF_R = OFF_X + 192 * MiB, OFF_K = OFF_R + 64 * MiB, OFF_V = OFF_K + 64 * MiB;
constexpr size_t OFF_LORA = OFF_X + 384 * MiB;
constexpr size_t OFF_YREC = OFF_X + 396 * MiB;
constexpr size_t OFF_GATE = OFF_X, OFF_REC = OFF_X + 64 * MiB, OFF_CV = OFF_X + 128 * MiB, OFF_CVB = OFF_X + 192 * MiB;
constexpr size_t OFF_AT = OFF_X + 224 * MiB, OFF_BT = OFF_X + 288 * MiB, OFF_AGGA = OFF_X + 352 * MiB, OFF_AGGH = OFF_X + 353 * MiB;
constexpr size_t OFF_U = OFF_X;
constexpr size_t OFF_H2 = OFF_X + 460 * MiB;
constexpr size_t OFF_BAR = OFF_H2 + 64 * MiB;
constexpr size_t OFF_BON = OFF_BAR + 1 * MiB;
constexpr size_t WS_END = OFF_BON + 1 * MiB;

constexpr int LDS_ST_OFF = 151552;
constexpr int LDS_BYTES = LDS_ST_OFF + 64;

struct Params {
    const float* in[31];
    float* out;
    unsigned char* ws;
    int ph_lo, ph_hi;
};

__device__ __forceinline__ const float* in_ptr(const Params& P, int i) { asm volatile("" : "+s"(i)); return P.in[i]; }
__device__ __forceinline__ unsigned cvt_pk_bf16(float lo, float hi) { unsigned r; asm volatile("v_cvt_pk_bf16_f32 %0, %1, %2" : "=v"(r) : "v"(lo), "v"(hi)); return r; }
__device__ __forceinline__ u32x2 pack4(f32x4 v) { u32x2 o; o.x = cvt_pk_bf16(v.x, v.y); o.y = cvt_pk_bf16(v.z, v.w); return o; }
__device__ __forceinline__ f32x4 unpack4(u32x2 u) { f32x4 o; o.x = __uint_as_float(u.x << 16); o.y = __uint_as_float(u.x & 0xffff0000u); o.z = __uint_as_float(u.y << 16); o.w = __uint_as_float(u.y & 0xffff0000u); return o; }
__device__ __forceinline__ void unpack8(u32x4 u, f32x4& a, f32x4& b) { a = unpack4((u32x2){u.x, u.y}); b = unpack4((u32x2){u.z, u.w}); }
__device__ __forceinline__ float wave_sum(float v) {
#pragma unroll
    for (int o = 1; o < 64; o <<= 1) v += __shfl_xor(v, o);
    return v;
}
__device__ __forceinline__ float sigmoidf_(float x) { return __builtin_amdgcn_rcpf(1.f + __expf(-x)); }
__device__ __forceinline__ float tanhf_(float x) { const float xc = fminf(fmaxf(x, -15.f), 15.f); return 1.f - 2.f * __builtin_amdgcn_rcpf(1.f + __expf(2.f * xc)); }
__device__ __forceinline__ float gelu_tanh(float x) { const float u = 0.7978845608028654f * (x + 0.044715f * x * x * x); return 0.5f * x * (1.f + tanhf_(u)); }
__device__ __forceinline__ float neg_expm1(float x) { return (fabsf(x) < 0.02f) ? -x * (1.f + x * (0.5f + x * (0.16666667f + x * 0.041666668f))) : 1.f - __expf(x); }
__device__ __forceinline__ int otid() { int t; asm volatile("v_mov_b32 %0, %1" : "=v"(t) : "v"((int)threadIdx.x)); return t; }
__device__ __forceinline__ int obid() { int t; asm volatile("s_mov_b32 %0, %1" : "=s"(t) : "s"((int)blockIdx.x)); return t; }
template <int CTRL> __device__ __forceinline__ float dpp_f(float v) { return __builtin_bit_cast(float, __builtin_amdgcn_update_dpp(0, __builtin_bit_cast(int, v), CTRL, 0xf, 0xf, false)); }
__device__ __forceinline__ float row16_allsum(float p) {
    p += dpp_f<0x128>(p); p += dpp_f<0x124>(p); p += dpp_f<0x122>(p); p += dpp_f<0x121>(p); return p;
}

namespace pg8 {
constexpr int BM = 256, BK = 64, HALF = 128, HTB = HALF * BK * 2, STAGE_BYTES = 8 * HTB, NXCD = 8, WGM = 8;
__host__ __device__ __forceinline__ int lds_byte(int r, int c) { const int st = (r >> 4) * 2 + (c >> 5), rr = r & 15, cc = c & 31, ob = rr * 64 + cc * 2; return st * 1024 + (ob ^ (((ob >> 9) & 1) << 5)); }
__host__ __device__ __forceinline__ void stage_rc(int b, int& R, int& C) { const int st = b / 1024, sb = b % 1024, swz = sb ^ (((sb >> 9) & 1) << 5); R = (st >> 1) * 16 + swz / 64; C = (st & 1) * 32 + (swz % 64) / 2; }
__host__ __device__ __forceinline__ int perm32(int rho) { const int n = rho >> 4, i = rho & 15; return 8 * (i >> 2) + 4 * n + (i & 3); }
struct Unit { int pm, pn; };
struct Gemm { const bf16_t* A; const bf16_t* Bt; int M, N, K, lda, ldb; };
template <int AMODE> struct Order {
    int nM, nN, nwg, G, c;
    __device__ void init(int M, int N, int G_, int c_) { nM = M / BM; nN = N / BM; nwg = nM * nN; G = G_; c = c_; }
    __device__ bool next(int i, Unit& u) const {
        const long L = (long)i * G + c; if (L >= nwg) return false;
        int wgid = (int)L; { const int q = nwg / NXCD, r = nwg % NXCD, xcd = wgid % NXCD, off = wgid / NXCD; wgid = (xcd < r ? xcd * (q + 1) : r * (q + 1) + (xcd - r) * q) + off; }
        const int nig = WGM * nN, gid = wgid / nig, fm = gid * WGM, gsz = (nM - fm) < WGM ? (nM - fm) : WGM;
        u.pm = fm + ((wgid % nig) % gsz); u.pn = (wgid % nig) / gsz; return true;
    }
    __device__ __forceinline__ size_t a_off(const Unit& u) const {
        if (AMODE == 1) return (size_t)(u.pn >> 1) * 512;
        if (AMODE == 2) { const int w = u.pn < 24 ? (u.pn >> 3) : (u.pn - 21); return (size_t)w * TD * 2; }
        if (AMODE == 3) return (size_t)(u.pn >> 3) * ((size_t)T * 256 * 2);
        return 0;
    }
};

#ifndef PG8_SP2
#define PG8_SP2 true
#endif
#ifndef PG8_ALIGN
#define PG8_ALIGN true
#endif
template <class Epi, class Sched, bool ALIGN_EPI = PG8_ALIGN, bool SP2 = PG8_SP2>
__device__ __forceinline__ void gemm_phase(LAS unsigned char* lds, const Gemm g, const Sched& S, const Epi& E) {
    int tid; asm volatile("v_mov_b32 %0, %1" : "=v"(tid) : "v"((int)threadIdx.x));
    const int wid = __builtin_amdgcn_readfirstlane(tid >> 6), lane = tid & 63, wr = wid >> 2, wc = wid & 3, fr = lane & 15, fq = lane >> 4;
    const int K = g.K, nt = K / BK;
    unsigned voffA[2], voffB[2];
#pragma unroll
    for (int i = 0; i < 2; ++i) { int R, C; stage_rc(tid * 16 + i * 8192, R, C);
        const int Rb = Epi::PERM ? ((R & ~31) + perm32(R & 31)) : R;
        voffA[i] = (unsigned)(R * g.lda + C) * 2u; voffB[i] = (unsigned)(Rb * g.ldb + C) * 2u; }
    const size_t kstep = (size_t)(BK * 2);
    const size_t hstepA = (size_t)HALF * g.lda * 2, hstepB = (size_t)HALF * g.ldb * 2;
    const size_t tstepA = 2 * hstepA, tstepB = 2 * hstepB;
    const unsigned ldsw = (unsigned)wid * 1024u;
    const int aoff = lds_byte(wr * 64 + fr, fq * 8), boff = lds_byte(wc * 32 + fr, fq * 8);
#define PG8_SA(b, h) (((b) * 2 + (h)) * HTB)
#define PG8_SB(b, h) ((4 + (b) * 2 + (h)) * HTB)
#define PG8_STAGE(bufoff, gbase, voff) do { _Pragma("unroll") for (int _i = 0; _i < 2; ++_i) \
        __builtin_amdgcn_global_load_lds((const unsigned*)((const char*)(gbase) + (voff)[_i]), (LAS unsigned*)(lds + (bufoff) + ldsw + _i * 8192), 16, 0, 0); } while (0)
#define PG8_LDA(dst, b, h) do { _Pragma("unroll") for (int m = 0; m < 4; ++m) _Pragma("unroll") for (int k = 0; k < 2; ++k) dst[m][k] = *(const LAS bf16x8*)(lds + PG8_SA(b, h) + aoff + m * 2048 + k * 1024); } while (0)
#define PG8_LDB(dst, b, h) do { _Pragma("unroll") for (int n = 0; n < 2; ++n) _Pragma("unroll") for (int k = 0; k < 2; ++k) dst[n][k] = *(const LAS bf16x8*)(lds + PG8_SB(b, h) + boff + n * 2048 + k * 1024); } while (0)
#define PG8_MMA(ai, bj, At, Bt) do { __builtin_amdgcn_s_setprio(1); _Pragma("unroll") for (int m = 0; m < 4; ++m) _Pragma("unroll") for (int n = 0; n < 2; ++n) _Pragma("unroll") for (int k = 0; k < 2; ++k) \
        acc[ai][bj][m][n] = __builtin_amdgcn_mfma_f32_16x16x32_bf16(Bt[n][k], At[m][k], acc[ai][bj][m][n], 0, 0, 0); __builtin_amdgcn_s_setprio(0); } while (0)
#define PG8_WAIT_V(n) asm volatile("s_waitcnt vmcnt(" #n ")" ::: "memory")
#define PG8_WAIT_L(n) asm volatile("s_waitcnt lgkmcnt(" #n ")" ::: "memory")
#define PG8_BAR __builtin_amdgcn_s_barrier()
#define PG8_SCHED __builtin_amdgcn_sched_barrier(0)
    Unit cur, nxt; int ui = 0;
    if (!S.next(0, cur)) return;
    f32x4 acc[2][2][4][2];
#pragma unroll
    for (int a = 0; a < 2; ++a)
#pragma unroll
        for (int b = 0; b < 2; ++b)
#pragma unroll
            for (int m = 0; m < 4; ++m)
#pragma unroll
                for (int n = 0; n < 2; ++n) acc[a][b][m][n] = (f32x4){0.f, 0.f, 0.f, 0.f};
    bf16x8 At[4][2], B0[2][2], B1[2][2];
    const char* cA = (const char*)g.A + (size_t)cur.pm * tstepA + S.a_off(cur); const char* cB = (const char*)g.Bt + (size_t)cur.pn * tstepB;
    if constexpr (SP2) {
        PG8_STAGE(PG8_SB(0, 0), cB, voffB); PG8_STAGE(PG8_SB(0, 1), cB + hstepB, voffB); PG8_STAGE(PG8_SA(0, 0), cA, voffA); PG8_STAGE(PG8_SA(0, 1), cA + hstepA, voffA);
        if (wr == 1) PG8_BAR;
        PG8_WAIT_V(2); PG8_BAR;
        PG8_STAGE(PG8_SB(1, 0), cB + kstep, voffB); PG8_STAGE(PG8_SA(1, 0), cA + kstep, voffA); PG8_STAGE(PG8_SB(1, 1), cB + hstepB + kstep, voffB);
        PG8_WAIT_V(6); PG8_BAR;
    } else {
        PG8_STAGE(PG8_SB(0, 0), cB, voffB); PG8_STAGE(PG8_SA(0, 0), cA, voffA); PG8_STAGE(PG8_SB(0, 1), cB + hstepB, voffB); PG8_STAGE(PG8_SA(0, 1), cA + hstepA, voffA);
        if (wr == 1) PG8_BAR;
        PG8_WAIT_V(4); PG8_BAR;
        PG8_STAGE(PG8_SB(1, 0), cB + kstep, voffB); PG8_STAGE(PG8_SA(1, 0), cA + kstep, voffA); PG8_STAGE(PG8_SB(1, 1), cB + hstepB + kstep, voffB);
        PG8_WAIT_V(6); PG8_BAR;
    }
    for (;;) {
        const bool has_next = S.next(ui + 1, nxt);
        const char* nA = has_next ? (const char*)g.A + (size_t)nxt.pm * tstepA + S.a_off(nxt) : cA; const char* nB = has_next ? (const char*)g.Bt + (size_t)nxt.pn * tstepB : cB;
#pragma unroll 1
        for (int t = 0; t < nt; t += 2) {
            const bool last = (t == nt - 2);
            const char* a1 = cA + (size_t)(t + 1) * kstep;
            const char* a2 = last ? nA : cA + (size_t)(t + 2) * kstep; const char* b2 = last ? nB : cB + (size_t)(t + 2) * kstep;
            const char* a3 = a2 + kstep; const char* b3 = b2 + kstep;
            if constexpr (SP2) {
            PG8_LDB(B0, 0, 0); PG8_LDB(B1, 0, 1); PG8_SCHED; PG8_LDA(At, 0, 0); PG8_STAGE(PG8_SA(1, 1), a1 + hstepA, voffA);
            PG8_WAIT_V(8); PG8_WAIT_L(0); PG8_BAR; PG8_MMA(0, 0, At, B0); PG8_MMA(0, 1, At, B1); PG8_BAR; PG8_SCHED;
            PG8_LDA(At, 0, 1); PG8_STAGE(PG8_SB(0, 0), b2, voffB); PG8_STAGE(PG8_SB(0, 1), b2 + hstepB, voffB); PG8_STAGE(PG8_SA(0, 0), a2, voffA);
            PG8_WAIT_V(8); PG8_WAIT_L(0); PG8_BAR; PG8_MMA(1, 0, At, B0); PG8_MMA(1, 1, At, B1); PG8_BAR; PG8_SCHED;
            PG8_LDB(B0, 1, 0); PG8_LDB(B1, 1, 1); PG8_SCHED; PG8_LDA(At, 1, 0); PG8_STAGE(PG8_SA(0, 1), a2 + hstepA, voffA);
            PG8_WAIT_V(8); PG8_WAIT_L(0); PG8_BAR; PG8_MMA(0, 0, At, B0); PG8_MMA(0, 1, At, B1); PG8_BAR; PG8_SCHED;
            PG8_LDA(At, 1, 1); PG8_STAGE(PG8_SB(1, 0), b3, voffB); PG8_STAGE(PG8_SB(1, 1), b3 + hstepB, voffB); PG8_STAGE(PG8_SA(1, 0), a3, voffA);
            PG8_WAIT_V(8); PG8_WAIT_L(0); PG8_BAR; PG8_MMA(1, 0, At, B0); PG8_MMA(1, 1, At, B1); PG8_BAR; PG8_SCHED;
            } else {
            PG8_LDB(B0, 0, 0); PG8_SCHED; PG8_LDA(At, 0, 0); PG8_STAGE(PG8_SA(1, 1), a1 + hstepA, voffA);
            PG8_WAIT_L(8); PG8_BAR; PG8_WAIT_L(0); PG8_MMA(0, 0, At, B0); PG8_BAR; PG8_SCHED;
            PG8_LDB(B1, 0, 1); PG8_STAGE(PG8_SB(0, 0), b2, voffB);
            PG8_BAR; PG8_WAIT_L(0); PG8_MMA(0, 1, At, B1); PG8_BAR;
            PG8_LDA(At, 0, 1); PG8_STAGE(PG8_SA(0, 0), a2, voffA);
            PG8_BAR; PG8_WAIT_L(0); PG8_MMA(1, 0, At, B0); PG8_BAR; PG8_SCHED;
            PG8_STAGE(PG8_SB(0, 1), b2 + hstepB, voffB);
            PG8_WAIT_V(6); PG8_BAR; PG8_MMA(1, 1, At, B1); PG8_BAR;
            PG8_LDB(B0, 1, 0); PG8_SCHED; PG8_LDA(At, 1, 0); PG8_STAGE(PG8_SA(0, 1), a2 + hstepA, voffA);
            PG8_WAIT_L(8); PG8_BAR; PG8_WAIT_L(0); PG8_MMA(0, 0, At, B0); PG8_BAR; PG8_SCHED;
            PG8_LDB(B1, 1, 1); PG8_STAGE(PG8_SB(1, 0), b3, voffB);
            PG8_BAR; PG8_WAIT_L(0); PG8_MMA(0, 1, At, B1); PG8_BAR;
            PG8_LDA(At, 1, 1); PG8_STAGE(PG8_SA(1, 0), a3, voffA);
            PG8_BAR; PG8_WAIT_L(0); PG8_MMA(1, 0, At, B0); PG8_BAR; PG8_SCHED;
            PG8_STAGE(PG8_SB(1, 1), b3 + hstepB, voffB);
            PG8_WAIT_V(6); PG8_BAR; PG8_MMA(1, 1, At, B1); PG8_BAR;
                    }
        }
        if constexpr (ALIGN_EPI) { if (wr == 0) PG8_BAR; }
        E(acc, cur, wr, wc, fr, fq);
        if (!has_next) break;
#pragma unroll
        for (int a = 0; a < 2; ++a)
#pragma unroll
            for (int b = 0; b < 2; ++b)
#pragma unroll
                for (int m = 0; m < 4; ++m)
#pragma unroll
                    for (int n = 0; n < 2; ++n) acc[a][b][m][n] = (f32x4){0.f, 0.f, 0.f, 0.f};
        cur = nxt; cA = nA; cB = nB; ++ui;
        if constexpr (ALIGN_EPI) { if (wr == 1) PG8_BAR; }
    }
    PG8_WAIT_V(0);
    if constexpr (!ALIGN_EPI) { if (wr == 0) PG8_BAR; }
    PG8_BAR;
#undef PG8_SA
#undef PG8_SB
#undef PG8_STAGE
#undef PG8_LDA
#undef PG8_LDB
#undef PG8_MMA
#undef PG8_WAIT_V
#undef PG8_WAIT_L
#undef PG8_BAR
#undef PG8_SCHED
}
}
using pg8::Unit;
typedef f32x4 Acc[2][2][4][2];
__device__ __forceinline__ u32x4 pack8(f32x4 a, f32x4 b) { u32x4 o; o.x = cvt_pk_bf16(a.x, a.y); o.y = cvt_pk_bf16(a.z, a.w); o.z = cvt_pk_bf16(b.x, b.y); o.w = cvt_pk_bf16(b.z, b.w); return o; }

struct EpiResidual {
    static constexpr bool PERM = false;
    const float* src; float* out;
    __device__ __forceinline__ void operator()(const Acc& acc, const Unit& u, int wr, int wc, int fr, int fq) const {
        const int row0 = u.pm * 256 + wr * 64 + fr, col0 = u.pn * 256 + wc * 32 + 4 * fq;
#pragma unroll
        for (int ai = 0; ai < 2; ++ai)
#pragma unroll
            for (int m = 0; m < 4; ++m) { const size_t ro = (size_t)(row0 + ai * 128 + m * 16) * D + col0;
#pragma unroll
                for (int bj = 0; bj < 2; ++bj)
#pragma unroll
                    for (int n = 0; n < 2; ++n) { const size_t o = ro + bj * 128 + n * 16; *(f32x4*)(out + o) = *(const f32x4*)(src + o) + acc[ai][bj][m][n]; } }
    }
};
struct EpiInProj {
    static constexpr bool PERM = true;
    bf16_t* gate; bf16_t* rec;
    __device__ __forceinline__ void operator()(const Acc& acc, const Unit& u, int wr, int wc, int fr, int fq) const {
        const bool isg = u.pn < 8; bf16_t* dst = isg ? gate : rec;
        const int row0 = u.pm * 256 + wr * 64 + fr, col0 = (u.pn & 7) * 256 + wc * 32 + 8 * fq;
#pragma unroll
        for (int ai = 0; ai < 2; ++ai)
#pragma unroll
            for (int m = 0; m < 4; ++m) { const size_t ro = (size_t)(row0 + ai * 128 + m * 16) * D + col0;
#pragma unroll
                for (int bj = 0; bj < 2; ++bj) { f32x4 v0 = acc[ai][bj][m][0], v1 = acc[ai][bj][m][1];
                    if (isg) {
#pragma unroll
                        for (int j = 0; j < 4; ++j) { v0[j] = gelu_tanh(v0[j]); v1[j] = gelu_tanh(v1[j]); } }
                    *(u32x4*)(dst + ro + bj * 128) = pack8(v0, v1); } }
    }
};
struct EpiGates {
    static constexpr bool PERM = true;
    const float* gxb; const float* gab; const float* lam; const bf16_t* cv; bf16_t* at; bf16_t* bt;
    __device__ __forceinline__ void operator()(const Acc& acc, const Unit& u, int wr, int wc, int fr, int fq) const {
        const int row0 = u.pm * 256 + wr * 64 + fr, ch0 = (u.pn >> 1) * 256 + (u.pn & 1) * 128 + wc * 32 + 8 * fq;
        u32x4 cvr[2][4];
#pragma unroll
        for (int ai = 0; ai < 2; ++ai)
#pragma unroll
            for (int m = 0; m < 4; ++m) cvr[ai][m] = *(const u32x4*)(cv + (size_t)(row0 + ai * 128 + m * 16) * D + ch0);
        f32x4 bx[2], ba[2], ls[2];
#pragma unroll
        for (int n = 0; n < 2; ++n) { bx[n] = *(const f32x4*)(gxb + ch0 + 4 * n); ba[n] = *(const f32x4*)(gab + ch0 + 4 * n); const f32x4 lm = *(const f32x4*)(lam + ch0 + 4 * n);
#pragma unroll
            for (int j = 0; j < 4; ++j) ls[n][j] = -8.f * ((lm[j] > 0.f) ? __logf(1.f + __expf(-lm[j])) : (-lm[j] + __logf(1.f + __expf(lm[j])))); }
#pragma unroll
        for (int ai = 0; ai < 2; ++ai)
#pragma unroll
            for (int m = 0; m < 4; ++m) { const size_t o = (size_t)(row0 + ai * 128 + m * 16) * D + ch0;
                f32x4 cvv[2]; unpack8(cvr[ai][m], cvv[0], cvv[1]); f32x4 av[2], bv[2];
#pragma unroll
                for (int n = 0; n < 2; ++n) { const f32x4 gi = acc[ai][0][m][n], gr = acc[ai][1][m][n];
#pragma unroll
                    for (int j = 0; j < 4; ++j) { const float it = sigmoidf_(gi[j] + bx[n][j]), rt = sigmoidf_(gr[j] + ba[n][j]);
                        const float la = rt * ls[n][j]; av[n][j] = la; bv[n][j] = __builtin_amdgcn_sqrtf(fmaxf(1.f - __expf(2.f * la), 0.f)) * (it * cvv[n][j]); } }
                *(u32x4*)(at + o) = pack8(av[0], av[1]); *(u32x4*)(bt + o) = pack8(bv[0], bv[1]); }
    }
};
struct EpiRKV {
    static constexpr bool PERM = true;
    unsigned char* rkv; bf16_t* lora;
    __device__ __forceinline__ void operator()(const Acc& acc, const Unit& u, int wr, int wc, int fr, int fq) const {
        const int row0 = u.pm * 256 + wr * 64 + fr;
        if (u.pn < 24) {
            bf16_t* dst = (bf16_t*)(rkv + (size_t)(u.pn >> 3) * (64 * MiB)); const int col0 = (u.pn & 7) * 256 + wc * 32 + 8 * fq;
#pragma unroll
            for (int ai = 0; ai < 2; ++ai)
#pragma unroll
                for (int m = 0; m < 4; ++m) { const size_t ro = (size_t)(row0 + ai * 128 + m * 16) * D + col0;
#pragma unroll
                    for (int bj = 0; bj < 2; ++bj) *(u32x4*)(dst + ro + bj * 128) = pack8(acc[ai][bj][m][0], acc[ai][bj][m][1]); }
        } else {
            const int w = u.pn - 24; bf16_t* dst = lora + (size_t)w * T * 256; const int col0 = wc * 32 + 8 * fq;
#pragma unroll
            for (int ai = 0; ai < 2; ++ai)
#pragma unroll
                for (int m = 0; m < 4; ++m) { const size_t ro = (size_t)(row0 + ai * 128 + m * 16) * 256 + col0;
#pragma unroll
                    for (int bj = 0; bj < 2; ++bj) { f32x4 v0 = acc[ai][bj][m][0], v1 = acc[ai][bj][m][1];
                        if (w == 0) {
#pragma unroll
                            for (int j = 0; j < 4; ++j) { v0[j] = tanhf_(v0[j]); v1[j] = tanhf_(v1[j]); }
                        } else if (w == 2) {
#pragma unroll
                            for (int j = 0; j < 4; ++j) { v0[j] = sigmoidf_(v0[j]); v1[j] = sigmoidf_(v1[j]); } }
                        *(u32x4*)(dst + ro + bj * 128) = pack8(v0, v1); } }
        }
    }
};
struct EpiLoraUp {
    static constexpr bool PERM = true;
    const float* w0; const float* a0; float* dec;
    __device__ __forceinline__ void operator()(const Acc& acc, const Unit& u, int wr, int wc, int fr, int fq) const {
        const int w = u.pn >> 3; float* dst = dec + (size_t)w * TD; const float* bias = (w == 0) ? w0 : a0;
        const int row0 = u.pm * 256 + wr * 64 + fr, col0 = (u.pn & 7) * 256 + wc * 32 + 8 * fq;
#pragma unroll
        for (int bj = 0; bj < 2; ++bj) { const int c = col0 + bj * 128; const f32x4 bb0 = *(const f32x4*)(bias + c), bb1 = *(const f32x4*)(bias + c + 4);
#pragma unroll
            for (int ai = 0; ai < 2; ++ai)
#pragma unroll
                for (int m = 0; m < 4; ++m) { f32x4 v0 = acc[ai][bj][m][0], v1 = acc[ai][bj][m][1]; const size_t o = (size_t)(row0 + ai * 128 + m * 16) * D + c;
                    if (w == 0) {
#pragma unroll
                        for (int j = 0; j < 4; ++j) { v0[j] = __expf(-0.6065306597126334f * sigmoidf_(v0[j] + bb0[j])); v1[j] = __expf(-0.6065306597126334f * sigmoidf_(v1[j] + bb1[j])); }
                    } else if (w == 1) {
#pragma unroll
                        for (int j = 0; j < 4; ++j) { v0[j] = sigmoidf_(v0[j] + bb0[j]); v1[j] = sigmoidf_(v1[j] + bb1[j]); }
                    }
                    if (w == 2) *(u32x4*)((bf16_t*)dst + o) = pack8(v0, v1);
                    else { *(f32x4*)(dst + o) = v0; *(f32x4*)(dst + o + 4) = v1; } } }
    }
};
struct EpiUp {
    static constexpr bool PERM = true;
    bf16_t* U;
    __device__ __forceinline__ void operator()(const Acc& acc, const Unit& u, int wr, int wc, int fr, int fq) const {
        const int row0 = u.pm * 256 + wr * 64 + fr, col0 = u.pn * 256 + wc * 32 + 8 * fq;
#pragma unroll
        for (int ai = 0; ai < 2; ++ai)
#pragma unroll
            for (int m = 0; m < 4; ++m) { const size_t ro = (size_t)(row0 + ai * 128 + m * 16) * FF + col0;
#pragma unroll
                for (int bj = 0; bj < 2; ++bj) { f32x4 v0 = acc[ai][bj][m][0], v1 = acc[ai][bj][m][1];
#pragma unroll
                    for (int j = 0; j < 4; ++j) { const float r0 = fmaxf(v0[j], 0.f), r1 = fmaxf(v1[j], 0.f); v0[j] = r0 * r0; v1[j] = r1 * r1; }
                    *(u32x4*)(U + ro + bj * 128) = pack8(v0, v1); } }
    }
};

__device__ __forceinline__ void tr_load(f32x4 (&r)[8], const float* W, int K, int N, int k0, int n0, int lane) {
#pragma unroll
    for (int i = 0; i < 8; ++i) { const int k = k0 + 8 * i + (lane >> 3); r[i] = (k < K) ? __builtin_nontemporal_load((const f32x4*)(W + (size_t)k * N + n0 + (lane & 7) * 4)) : (f32x4){0.f, 0.f, 0.f, 0.f}; }
}
__device__ __forceinline__ void tr_store(const f32x4 (&r)[8], bf16_t* WT, int ldt, int dst_k0, int dst_row0, LAS float* scr, int lane) {
#pragma unroll
    for (int i = 0; i < 8; ++i) { LAS float* d = scr + (8 * i + (lane >> 3)) * 33 + (lane & 7) * 4; d[0] = r[i].x; d[1] = r[i].y; d[2] = r[i].z; d[3] = r[i].w; }
    asm volatile("s_waitcnt lgkmcnt(0)" ::: "memory");
    const int c = lane & 7;
#pragma unroll
    for (int j = 0; j < 4; ++j) { const int n = (lane >> 3) + 8 * j; const LAS float* s = scr + (8 * c) * 33 + n;
        u32x4 o; o.x = cvt_pk_bf16(s[0 * 33], s[1 * 33]); o.y = cvt_pk_bf16(s[2 * 33], s[3 * 33]); o.z = cvt_pk_bf16(s[4 * 33], s[5 * 33]); o.w = cvt_pk_bf16(s[6 * 33], s[7 * 33]);
        *(u32x4*)(WT + (size_t)(dst_row0 + n) * ldt + dst_k0 + 8 * c) = o; }
    asm volatile("s_waitcnt lgkmcnt(0)" ::: "memory");
}

__device__ __forceinline__ bf16_t* w_rg(const Params& P, int j, int which) { return (bf16_t*)(P.ws + OFF_W_RG + (size_t)j * SZ_W_RG + (which == 0 ? 0 : which == 1 ? 16 * MiB : 18 * MiB)); }
__device__ __forceinline__ bf16_t* w_rw(const Params& P, int j, int which) { return (bf16_t*)(P.ws + OFF_W_RW + (size_t)j * SZ_W_RW + (which == 0 ? 0 : which == 1 ? 27 * MiB : 30 * MiB)); }
__device__ __forceinline__ bf16_t* w_mlp(const Params& P, int i, int which) { return (bf16_t*)(P.ws + OFF_W_MLP + (size_t)i * SZ_W_MLP + (which == 0 ? 0 : 32 * MiB)); }

struct JobD { const float* W; bf16_t* WT; int K, N, ldt, nnb, nit, mode, aux; };
constexpr int NJOBS = 36;
__device__ __forceinline__ void get_job(const Params& P, int jid, JobD& d) {
    int src, Kpad; size_t soff; d.mode = 0; d.aux = 0;
    if (jid < 8) { const int i = jid >> 1;
        if (!(jid & 1)) { src = 3; soff = (size_t)i * D * FF; d.K = D; d.N = FF; d.WT = w_mlp(P, i, 0); d.ldt = D; Kpad = D; }
        else { src = 4; soff = (size_t)i * FF * D; d.K = FF; d.N = D; d.WT = w_mlp(P, i, 1); d.ldt = FF; Kpad = FF; }
    } else if (jid < 16) { const int j = (jid - 8) >> 2, q = (jid - 8) & 3;
        if (q == 0) { src = 6; soff = (size_t)j * D * 2 * D; d.K = D; d.N = 2 * D; d.WT = w_rg(P, j, 0); d.ldt = D; Kpad = D; }
        else if (q == 1) { src = 14; soff = (size_t)j * D * D; d.K = D; d.N = D; d.WT = w_rg(P, j, 2); d.ldt = D; Kpad = D; }
        else { src = (q == 2) ? 9 : 11; soff = (size_t)j * 8 * 65536; d.K = 2048; d.N = 256; d.WT = w_rg(P, j, 1); d.ldt = 256; Kpad = 2048; d.mode = 1; d.aux = (q == 2) ? 0 : 128; }
    } else { const int j = (jid - 16) / 10, q = (jid - 16) % 10; d.K = D; d.N = D; d.ldt = D; Kpad = D; d.WT = w_rw(P, j, 0);
        if (q < 3) { src = 16; soff = (size_t)(j * 3 + q) * D * D; d.aux = q * D; }
        else if (q == 3) { src = 18; soff = (size_t)j * D * 96; d.N = 96; d.aux = 6144; }
        else if (q == 4) { src = 21; soff = (size_t)j * D * 96; d.N = 96; d.aux = 6144 + 256; }
        else if (q == 5) { src = 23; soff = (size_t)j * D * 256; d.N = 256; d.aux = 6144 + 512; }
        else if (q == 6) { src = 19; soff = (size_t)j * 96 * D; d.K = 96; d.WT = w_rw(P, j, 1); d.ldt = 256; Kpad = 256; }
        else if (q == 7) { src = 22; soff = (size_t)j * 96 * D; d.K = 96; d.WT = w_rw(P, j, 1); d.ldt = 256; Kpad = 256; d.aux = 2048; }
        else if (q == 8) { src = 24; soff = (size_t)j * 256 * D; d.K = 256; d.WT = w_rw(P, j, 1); d.ldt = 256; Kpad = 256; d.aux = 4096; }
        else { src = 30; soff = (size_t)j * D * D; d.WT = w_rw(P, j, 2); }
    }
    d.W = in_ptr(P, __builtin_amdgcn_readfirstlane(src)) + soff; d.nnb = d.N / 32; d.nit = (Kpad / 64) * d.nnb;
}
__device__ __forceinline__ void convert_jobs(const Params& P, LAS unsigned char* lds, int jlo, int jhi, int gw, int NGW) {
    const int tid = otid(), lane = tid & 63, wave = __builtin_amdgcn_readfirstlane(tid >> 6);
    LAS float* scr = (LAS float*)(lds + wave * 16384);
    int jid = jlo, it = gw; JobD cj; get_job(P, jid, cj);
    while (it >= cj.nit) { it -= cj.nit; if (++jid >= jhi) return; get_job(P, jid, cj); }
    f32x4 r[8]; tr_load(r, cj.W, cj.K, cj.N, (it / cj.nnb) * 64, (it % cj.nnb) * 32, lane);
    for (;;) {
        int njid = jid, nit_ = it + NGW; JobD nj = cj; bool have = true;
        while (nit_ >= nj.nit) { nit_ -= nj.nit; if (++njid >= jhi) { have = false; break; } get_job(P, njid, nj); }
        f32x4 rn[8];
        if (have) tr_load(rn, nj.W, nj.K, nj.N, (nit_ / nj.nnb) * 64, (nit_ % nj.nnb) * 32, lane);
        else {
#pragma unroll
            for (int q = 0; q < 8; ++q) rn[q] = (f32x4){0.f, 0.f, 0.f, 0.f};
        }
        const int k0 = (it / cj.nnb) * 64, n0 = (it % cj.nnb) * 32;
        const int drow = (cj.mode == 1) ? (((k0 >> 8) * 2 + (n0 >> 7)) * 256 + cj.aux + (n0 & 127)) : (cj.aux + n0);
        const int dk0 = (cj.mode == 1) ? (k0 & 255) : k0;
        tr_store(r, cj.WT, cj.ldt, dk0, drow, scr, lane);
        if (!have) break;
#pragma unroll
        for (int q = 0; q < 8; ++q) r[q] = rn[q];
        jid = njid; it = nit_; cj = nj;
    }
}
__device__ __forceinline__ void phase_convert(const Params& P, LAS unsigned char* lds) {
    const int tid = otid(), bid = obid(), wave = __builtin_amdgcn_readfirstlane(tid >> 6);
    const int gw = bid * 8 + wave, NGW = gridDim.x * 8;
    for (int j = 0; j < 2; ++j) {
        u32x4* z0 = (u32x4*)(w_rw(P, j, 0) + (size_t)(6144 + 96) * D); u32x4* z1 = (u32x4*)(w_rw(P, j, 0) + (size_t)(6144 + 256 + 96) * D);
        for (int i = bid * 512 + tid; i < 40960; i += gridDim.x * 512) { z0[i] = (u32x4){0u, 0u, 0u, 0u}; z1[i] = (u32x4){0u, 0u, 0u, 0u}; }
    }
    convert_jobs(P, lds, 0, 4, gw, NGW);
    convert_jobs(P, lds, 8, NJOBS, gw, NGW);
}

template <bool F32OUT> __device__ __forceinline__ void phase_norm(const float* __restrict__ src, const float* __restrict__ g, bf16_t* __restrict__ dstb, float* __restrict__ dstf) {
    const int tid = otid(), lane = tid & 63, gw = obid() * 8 + (tid >> 6), NGW = gridDim.x * 8;
    for (int row = gw; row < T; row += NGW) {
        const f32x4* xr = (const f32x4*)(src + (size_t)row * D) + 2 * lane;
        f32x4 v[8]; float s = 0.f;
#pragma unroll
        for (int j = 0; j < 4; ++j) { v[2 * j] = xr[128 * j]; v[2 * j + 1] = xr[128 * j + 1];
            s += (v[2 * j].x * v[2 * j].x + v[2 * j].y * v[2 * j].y) + (v[2 * j].z * v[2 * j].z + v[2 * j].w * v[2 * j].w);
            s += (v[2 * j + 1].x * v[2 * j + 1].x + v[2 * j + 1].y * v[2 * j + 1].y) + (v[2 * j + 1].z * v[2 * j + 1].z + v[2 * j + 1].w * v[2 * j + 1].w); }
        const float sc = 1.f / sqrtf(wave_sum(s) * (1.f / D) + 1e-6f);
#pragma unroll
        for (int j = 0; j < 4; ++j) { const int i4 = 128 * j + 2 * lane; const f32x4 o0 = v[2 * j] * sc * ((const f32x4*)g)[i4], o1 = v[2 * j + 1] * sc * ((const f32x4*)g)[i4 + 1];
            if (F32OUT) { __builtin_nontemporal_store(o0, (f32x4*)(dstf + (size_t)row * D) + i4); __builtin_nontemporal_store(o1, (f32x4*)(dstf + (size_t)row * D) + i4 + 1); }
            else ((u32x4*)(dstb + (size_t)row * D))[64 * j + lane] = pack8(o0, o1); }
    }
}

__device__ __forceinline__ void phase_mix(const float* __restrict__ src, const float* __restrict__ g, const float* __restrict__ mu, bf16_t* __restrict__ xm) {
    const int tid = otid(), lane = tid & 63, gw = obid() * 8 + (tid >> 6), NGW = gridDim.x * 8;
    for (int row = gw; row < T; row += NGW) {
        const bool hasp = (row % S) != 0;
        const f32x4* x2 = (const f32x4*)(src + (size_t)row * D) + 2 * lane; const f32x4* p2 = x2 - (D / 4);
        const f32x4 z4 = {0.f, 0.f, 0.f, 0.f};
        f32x4 v[8], p[8]; float s = 0.f, sp = 0.f;
#pragma unroll
        for (int j = 0; j < 4; ++j) { v[2 * j] = x2[128 * j]; v[2 * j + 1] = x2[128 * j + 1]; p[2 * j] = hasp ? p2[128 * j] : z4; p[2 * j + 1] = hasp ? p2[128 * j + 1] : z4; }
#pragma unroll
        for (int i = 0; i < 8; ++i) { s += (v[i].x * v[i].x + v[i].y * v[i].y) + (v[i].z * v[i].z + v[i].w * v[i].w); sp += (p[i].x * p[i].x + p[i].y * p[i].y) + (p[i].z * p[i].z + p[i].w * p[i].w); }
        const float sc = 1.f / sqrtf(wave_sum(s) * (1.f / D) + 1e-6f), scp = 1.f / sqrtf(wave_sum(sp) * (1.f / D) + 1e-6f);
#pragma unroll
        for (int j = 0; j < 4; ++j) { const int i4 = 128 * j + 2 * lane;
            const f32x4 g0 = ((const f32x4*)g)[i4], g1 = ((const f32x4*)g)[i4 + 1];
            const f32x4 hn0 = v[2 * j] * sc * g0, hn1 = v[2 * j + 1] * sc * g1, xx0 = p[2 * j] * scp * g0 - hn0, xx1 = p[2 * j + 1] * scp * g1 - hn1;
#pragma unroll
            for (int q = 0; q < 6; ++q) { const f32x4 m0 = ((const f32x4*)(mu + q * D))[i4], m1 = ((const f32x4*)(mu + q * D))[i4 + 1];
                ((u32x4*)(xm + (size_t)q * TD + (size_t)row * D))[64 * j + lane] = pack8(hn0 + xx0 * m0, hn1 + xx1 * m1); }
            __builtin_amdgcn_sched_barrier(0); }
    }
}

__device__ __forceinline__ void phase_conv(const bf16_t* __restrict__ rec, const float* __restrict__ cw, const float* __restrict__ cb, bf16_t* __restrict__ cvb) {
    const int n8 = T * (D / 8);
    for (int idx = obid() * 512 + otid(); idx < n8; idx += gridDim.x * 512) {
        const int row = idx / (D / 8), c8 = idx % (D / 8), t = row % S;
        f32x4 a0 = ((const f32x4*)cb)[2 * c8], a1 = ((const f32x4*)cb)[2 * c8 + 1];
#pragma unroll
        for (int k = 0; k < 4; ++k) { const int dt = 3 - k; if (t - dt >= 0) { f32x4 r0, r1; unpack8(((const u32x4*)(rec + (size_t)(row - dt) * D))[c8], r0, r1);
            a0 += ((const f32x4*)(cw + k * D))[2 * c8] * r0; a1 += ((const f32x4*)(cw + k * D))[2 * c8 + 1] * r1; } }
        ((u32x4*)cvb)[idx] = pack8(a0, a1);
    }
}

__device__ __forceinline__ void phase_scan1(const bf16_t* __restrict__ at, const bf16_t* __restrict__ bt, float* __restrict__ agga, float* __restrict__ aggh) {
    const int tid = otid();
    for (int item = obid(); item < 256; item += gridDim.x) {
        const int b = item >> 7, chunk = (item >> 1) & 63, half = item & 1, c = half * 1024 + 2 * tid;
        const size_t r0 = (size_t)(b * S + chunk * 64) * D + c;
        f32x2 hh = {0.f, 0.f}, pp = {1.f, 1.f};
#pragma unroll 16
        for (int t = 0; t < 64; ++t) { const size_t o = r0 + (size_t)t * D; const unsigned au = *(const unsigned*)(at + o), bu = *(const unsigned*)(bt + o);
            const f32x2 a2 = {__expf(__uint_as_float(au << 16)), __expf(__uint_as_float(au & 0xffff0000u))}, b2 = {__uint_as_float(bu << 16), __uint_as_float(bu & 0xffff0000u)};
            hh = a2 * hh + b2; pp = pp * a2; }
        const size_t ao = (size_t)(b * 64 + chunk) * D + c; *(f32x2*)(agga + ao) = pp; *(f32x2*)(aggh + ao) = hh;
    }
}
__device__ __forceinline__ void phase_scan2(const bf16_t* __restrict__ at, const bf16_t* __restrict__ bt, const float* __restrict__ agga, const float* __restrict__ aggh, const bf16_t* __restrict__ gate, bf16_t* __restrict__ acta) {
    const int tid = otid();
    for (int item = obid(); item < 256; item += gridDim.x) {
        const int b = item >> 7, chunk = (item >> 1) & 63, half = item & 1, c = half * 1024 + 2 * tid;
        f32x2 hh = {0.f, 0.f};
        for (int k = 0; k < chunk; ++k) { const size_t ao = (size_t)(b * 64 + k) * D + c; hh = *(const f32x2*)(agga + ao) * hh + *(const f32x2*)(aggh + ao); }
        const size_t r0 = (size_t)(b * S + chunk * 64) * D + c;
#pragma unroll 16
        for (int t = 0; t < 64; ++t) { const size_t o = r0 + (size_t)t * D; const unsigned au = __builtin_nontemporal_load((const unsigned*)(at + o)), bu = __builtin_nontemporal_load((const unsigned*)(bt + o)), gu = __builtin_nontemporal_load((const unsigned*)(gate + o));
            const f32x2 a2 = {__expf(__uint_as_float(au << 16)), __expf(__uint_as_float(au & 0xffff0000u))}, b2 = {__uint_as_float(bu << 16), __uint_as_float(bu & 0xffff0000u)};
            hh = a2 * hh + b2;
            *(unsigned*)(acta + o) = cvt_pk_bf16(hh.x * __uint_as_float(gu << 16), hh.y * __uint_as_float(gu & 0xffff0000u)); }
    }
}

__device__ __forceinline__ void phase_recur(const bf16_t* Rg, const bf16_t* Kg, const bf16_t* Vg, const float* DECg, const float* AAg,
                                            const float* k_k, const float* k_a, const float* r_k, float* BON, float* Yg, LAS unsigned char* lds) {
    constexpr int CH = 32, NCH = S / CH;
    constexpr int OFF_V_ = 5 * CH * 64, OFF_YP = OFF_V_ + CH * 16, BUF_F = OFF_YP + CH * 256;
    LAS float* L = (LAS float*)lds;
    const int tid = otid(), wave = tid >> 6, lane = tid & 63;
    for (int it0 = obid(); it0 < 256; it0 += gridDim.x) {
        const int item = (gridDim.x == 256) ? ((it0 & 7) * 32 + (it0 >> 3)) : it0;
        const int b = item >> 7, hh = (item >> 2) & 31, q = item & 3;
        const size_t rowbase = (size_t)b * S;
        const int colh = hh * 64;
        const int ltid = tid - 256, lt = (ltid >> 4) & 15, lj0 = (ltid & 15) * 4, vt = (ltid >> 2) & 31, vi = (ltid & 3) * 4;
        const bool vldr = ltid < 128;
        __syncthreads();
        if (wave >= 4) {
            const f32x4 kkc = *(const f32x4*)(k_k + colh + lj0), kac = *(const f32x4*)(k_a + colh + lj0), rkc = *(const f32x4*)(r_k + colh + lj0);
            f32x4 ga0A = {0, 0, 0, 0}, ga1A = {0, 0, 0, 0}, gd0A = {0, 0, 0, 0}, gd1A = {0, 0, 0, 0}; u32x2 gk0A = {0, 0}, gk1A = {0, 0}, gr0A = {0, 0}, gr1A = {0, 0}, gvrA = {0, 0};
            f32x4 ga0B = {0, 0, 0, 0}, ga1B = {0, 0, 0, 0}, gd0B = {0, 0, 0, 0}, gd1B = {0, 0, 0, 0}; u32x2 gk0B = {0, 0}, gk1B = {0, 0}, gr0B = {0, 0}, gr1B = {0, 0}, gvrB = {0, 0};
#define RC_GLOAD(X, ch) do { if ((ch) < NCH) { const size_t go = (rowbase + (size_t)(ch) * CH + lt) * D + colh + lj0, go1 = go + (size_t)16 * D; \
                gk0##X = *(const u32x2*)(Kg + go); gr0##X = *(const u32x2*)(Rg + go); ga0##X = *(const f32x4*)(AAg + go); gd0##X = *(const f32x4*)(DECg + go); \
                gk1##X = *(const u32x2*)(Kg + go1); gr1##X = *(const u32x2*)(Rg + go1); ga1##X = *(const f32x4*)(AAg + go1); gd1##X = *(const f32x4*)(DECg + go1); \
                if (vldr) gvr##X = *(const u32x2*)(Vg + (rowbase + (size_t)(ch) * CH + vt) * D + colh + q * 16 + vi); } } while (0)
#define RC_LW1(B, kraw, rraw, av, dv, tt, chk) do { const f32x4 kf = unpack4(kraw), rf = unpack4(rraw); f32x4 nn = kf * kkc; \
                const float ss = row16_allsum((nn.x * nn.x + nn.y * nn.y) + (nn.z * nn.z + nn.w * nn.w)); \
                const float inv = __builtin_amdgcn_rcpf(fmaxf(__builtin_amdgcn_sqrtf(ss), 1e-12f)); nn = nn * inv; \
                const f32x4 one = {1.f, 1.f, 1.f, 1.f}; const int lo = (tt) * 64 + lj0; const f32x4 km = kf * (one + (av - one) * kac), bt_ = rf * km * rkc; \
                const float bs = row16_allsum((bt_.x + bt_.y) + (bt_.z + bt_.w)); \
                if (q == 0 && (ltid & 15) == 0) BON[(rowbase + (size_t)(chk) * CH + (tt)) * 32 + hh] = bs;     \
                *(LAS f32x4*)(B + 0 * CH * 64 + lo) = dv; *(LAS f32x4*)(B + 1 * CH * 64 + lo) = nn; *(LAS f32x4*)(B + 2 * CH * 64 + lo) = nn * av; \
                *(LAS f32x4*)(B + 3 * CH * 64 + lo) = km; *(LAS f32x4*)(B + 4 * CH * 64 + lo) = rf; } while (0)
#define RC_LWRITE(X, buf, chk) do { LAS float* B = L + (buf) * BUF_F; RC_LW1(B, gk0##X, gr0##X, ga0##X, gd0##X, lt, chk); RC_LW1(B, gk1##X, gr1##X, ga1##X, gd1##X, lt + 16, chk); \
                if (vldr) *(LAS f32x4*)(B + OFF_V_ + vt * 16 + vi) = unpack4(gvr##X); } while (0)
#define RC_FLUSH(ch, buf) do { if (wave >= 6) { const LAS float* Bp = L + (buf) * BUF_F + OFF_YP + (wave - 6) * 16 * 256 + lane * 4; \
                float* yo = Yg + (rowbase + (size_t)(ch) * CH + (wave - 6) * 16) * D + colh + q * 16 + (lane >> 2); \
                _Pragma("unroll") for (int _i = 0; _i < 16; ++_i) { const f32x4 p4 = *(const LAS f32x4*)(Bp + _i * 256); float sq = (p4.x + p4.y) + (p4.z + p4.w); \
                    sq += dpp_f<0xB1>(sq); sq += dpp_f<0x4E>(sq); if ((lane & 3) == 0) yo[(size_t)_i * D] = sq; } } } while (0)
            RC_GLOAD(A, 0); RC_LWRITE(A, 0, 0); RC_GLOAD(A, 1); RC_GLOAD(B, 2);
            __syncthreads();
            for (int ch = 0; ch < NCH; ch += 2) {
                RC_LWRITE(A, 1, ch + 1); RC_GLOAD(A, ch + 3);
                if (ch >= 1) RC_FLUSH(ch - 1, 1);
                __syncthreads();
                if (ch + 2 < NCH) { RC_LWRITE(B, 0, ch + 2); RC_GLOAD(B, ch + 4); }
                RC_FLUSH(ch, 0);
                __syncthreads();
            }
            RC_FLUSH(NCH - 1, 1);
#undef RC_GLOAD
#undef RC_LW1
#undef RC_LWRITE
#undef RC_FLUSH
        } else {
            __syncthreads();
            const int rl = wave * 4 + (lane >> 4), js = lane & 15;
            f32x2 sa = {0.f, 0.f}, sb = {0.f, 0.f};
            for (int ch = 0; ch < NCH; ++ch) {
                LAS float* B = L + (ch & 1) * BUF_F;
                const LAS float* pj = B + js * 4; const LAS float* pv = B + OFF_V_ + rl; LAS float* py = B + OFF_YP + rl * 16 + js;
                f32x4 w4 = *(const LAS f32x4*)(pj + 0 * CH * 64), k4 = *(const LAS f32x4*)(pj + 1 * CH * 64), b4 = *(const LAS f32x4*)(pj + 2 * CH * 64);
                f32x4 m4 = *(const LAS f32x4*)(pj + 3 * CH * 64), r4 = *(const LAS f32x4*)(pj + 4 * CH * 64); float v = pv[0];
#pragma unroll
                for (int t = 0; t < CH; ++t) {
                    const int tn = (t + 1 < CH) ? t + 1 : t;
                    const f32x4 w4n = *(const LAS f32x4*)(pj + 0 * CH * 64 + tn * 64), k4n = *(const LAS f32x4*)(pj + 1 * CH * 64 + tn * 64), b4n = *(const LAS f32x4*)(pj + 2 * CH * 64 + tn * 64);
                    const f32x4 m4n = *(const LAS f32x4*)(pj + 3 * CH * 64 + tn * 64), r4n = *(const LAS f32x4*)(pj + 4 * CH * 64 + tn * 64); const float vn = pv[tn * 16];
                    const f32x2 pk = sa * k4.xy + sb * k4.zw;
                    const float p = row16_allsum(pk.x + pk.y);
                    const f32x2 pp = {p, p}, vv = {v, v};
                    sa = sa * w4.xy + (vv * m4.xy - pp * b4.xy);
                    sb = sb * w4.zw + (vv * m4.zw - pp * b4.zw);
                    const f32x2 yk = sa * r4.xy + sb * r4.zw;
                    py[t * 256] = yk.x + yk.y;
                    w4 = w4n; k4 = k4n; b4 = b4n; m4 = m4n; r4 = r4n; v = vn;
                }
                __syncthreads();
            }
        }
    }
}

__device__ __forceinline__ float oct_allsum(float x) {
    x += dpp_f<0x141>(x); x += dpp_f<0x4E>(x); x += dpp_f<0xB1>(x); return x;
}
__device__ __forceinline__ void phase_gn(const float* __restrict__ Yg, const bf16_t* __restrict__ Vg, const bf16_t* __restrict__ GGg, const float* __restrict__ BON,
                                         const float* __restrict__ ln_g, const float* __restrict__ ln_b, bf16_t* __restrict__ acta) {
    const int tid = otid(), lane = tid & 63, gw = obid() * 8 + (tid >> 6), NGW = gridDim.x * 8;
    for (int row = gw; row < T; row += NGW) {
        const size_t ro = (size_t)row * D;
#pragma unroll 2
        for (int j = 0; j < 4; ++j) { const int c = (64 * j + lane) * 8; const size_t o = ro + c;
            const f32x4 y0 = __builtin_nontemporal_load((const f32x4*)(Yg + o)), y1 = __builtin_nontemporal_load((const f32x4*)(Yg + o + 4));
            f32x4 v0, v1, g0, g1;
            unpack8(__builtin_nontemporal_load((const u32x4*)(Vg + o)), v0, v1); unpack8(__builtin_nontemporal_load((const u32x4*)(GGg + o)), g0, g1);
            const float sb = BON[(size_t)row * 32 + (c >> 6)];
            const f32x4 lg0 = *(const f32x4*)(ln_g + c), lg1 = *(const f32x4*)(ln_g + c + 4), lb0 = *(const f32x4*)(ln_b + c), lb1 = *(const f32x4*)(ln_b + c + 4);
            float sm = ((y0.x + y0.y) + (y0.z + y0.w)) + ((y1.x + y1.y) + (y1.z + y1.w));
            sm = oct_allsum(sm);
            const float mean = sm * (1.f / 64.f); const f32x4 d0 = y0 - mean, d1 = y1 - mean;
            float sv = ((d0.x * d0.x + d0.y * d0.y) + (d0.z * d0.z + d0.w * d0.w)) + ((d1.x * d1.x + d1.y * d1.y) + (d1.z * d1.z + d1.w * d1.w)); sv = oct_allsum(sv);
            const float rstd = 1.f / sqrtf(sv * (1.f / 64.f) + 64e-5f);
            *(u32x4*)(acta + o) = pack8((d0 * rstd * lg0 + lb0 + v0 * sb) * g0, (d1 * rstd * lg1 + lb1 + v1 * sb) * g1); }
    }
}

__device__ __forceinline__ void run_phase(const Params& P, int ph, LAS unsigned char* lds) {
    unsigned char* ws = P.ws;
    float* H0 = (float*)(ws + OFF_H); float* H1 = (float*)(ws + OFF_H2); bf16_t* ACTA = (bf16_t*)(ws + OFF_ACTA);
    const int G = gridDim.x, c = obid();
    if (ph == 0) { if constexpr (KEN(20)) { phase_convert(P, lds); phase_norm<false>(in_ptr(P, 0), in_ptr(P, 1), ACTA, nullptr); } return; }
    if (ph == 39) { if constexpr (KEN(21)) phase_norm<true>(H1, in_ptr(P, 5), nullptr, P.out); return; }
    const int p = ph - 1, pair = p / 19, r = p % 19;
    const bool is_rg = r < 10; const int layer = 2 * pair + (is_rg ? 0 : 1), sub = is_rg ? r : r - 10, j = pair;
    const float* hsrc = (layer == 0) ? in_ptr(P, 0) : H1;
    int kind;
    if (is_rg) kind = sub; else kind = (sub < 5) ? 10 + sub : sub + 1;
    switch (kind) {
    case 0: if constexpr (KEN(0)) phase_norm<false>(hsrc, in_ptr(P, 1) + (size_t)layer * D, ACTA, nullptr); break;
    case 7: if constexpr (KEN(0)) phase_norm<false>(H0, in_ptr(P, 2) + (size_t)layer * D, ACTA, nullptr); break;
    case 1: if constexpr (KEN(1)) { pg8::Gemm g{ACTA, w_rg(P, j, 0), T, 2 * D, D, D, D}; pg8::Order<0> So; So.init(T, 2 * D, G, c);
        EpiInProj E{(bf16_t*)(ws + OFF_GATE), (bf16_t*)(ws + OFF_REC)}; pg8::gemm_phase(lds, g, So, E); break; }
    case 2: if constexpr (KEN(2)) phase_conv((const bf16_t*)(ws + OFF_REC), in_ptr(P, 7) + (size_t)j * 4 * D, in_ptr(P, 8) + (size_t)j * D, (bf16_t*)(ws + OFF_CVB)); break;
    case 3: if constexpr (KEN(3)) { pg8::Gemm g{(const bf16_t*)(ws + OFF_CVB), w_rg(P, j, 1), T, 2 * D, 256, D, 256}; pg8::Order<1> So; So.init(T, 2 * D, G, c);
        EpiGates E{in_ptr(P, 10) + (size_t)j * D, in_ptr(P, 12) + (size_t)j * D, in_ptr(P, 13) + (size_t)j * D, (const bf16_t*)(ws + OFF_CVB), (bf16_t*)(ws + OFF_AT), (bf16_t*)(ws + OFF_BT)};
        pg8::gemm_phase(lds, g, So, E); break; }
    case 4: if constexpr (KEN(4)) phase_scan1((const bf16_t*)(ws + OFF_AT), (const bf16_t*)(ws + OFF_BT), (float*)(ws + OFF_AGGA), (float*)(ws + OFF_AGGH)); break;
    case 5: if constexpr (KEN(5)) phase_scan2((const bf16_t*)(ws + OFF_AT), (const bf16_t*)(ws + OFF_BT), (const float*)(ws + OFF_AGGA), (const float*)(ws + OFF_AGGH), (const bf16_t*)(ws + OFF_GATE), ACTA); break;
    case 6: case 9: if constexpr (KEN(6)) { const bool down = (kind == 9);
        const bf16_t* A = down ? (const bf16_t*)(ws + OFF_U) : ACTA; const bf16_t* Bt = down ? w_mlp(P, layer, 1) : (is_rg ? w_rg(P, j, 2) : w_rw(P, j, 2));
        const int K = down ? FF : D; pg8::Gemm g{A, Bt, T, D, K, K, K}; pg8::Order<0> So; So.init(T, D, G, c);
        EpiResidual E{down ? (const float*)H0 : hsrc, down ? H1 : H0}; pg8::gemm_phase(lds, g, So, E); break; }
    case 8: if constexpr (KEN(8)) { pg8::Gemm g{ACTA, w_mlp(P, layer, 0), T, FF, D, D, D}; pg8::Order<0> So; So.init(T, FF, G, c);
        EpiUp E{(bf16_t*)(ws + OFF_U)}; pg8::gemm_phase(lds, g, So, E); break; }
    case 10: if constexpr (KEN(10)) phase_mix(hsrc, in_ptr(P, 1) + (size_t)layer * D, in_ptr(P, 15) + (size_t)j * 6 * D, (bf16_t*)(ws + OFF_XM)); break;
    case 11: if constexpr (KEN(11)) { pg8::Gemm g{(const bf16_t*)(ws + OFF_XM), w_rw(P, j, 0), T, 6912, D, D, D}; pg8::Order<2> So; So.init(T, 6912, G, c);
        EpiRKV E{ws + OFF_R, (bf16_t*)(ws + OFF_LORA)}; pg8::gemm_phase(lds, g, So, E);
        { const int nfull = 864 % G; if (nfull != 0 && c >= nfull) { const int wv = __builtin_amdgcn_readfirstlane(otid() >> 6); convert_jobs(P, lds, 4 + 2 * j, 6 + 2 * j, (c - nfull) * 8 + wv, (G - nfull) * 8); }
          else if (nfull == 0) { const int wv = __builtin_amdgcn_readfirstlane(otid() >> 6); convert_jobs(P, lds, 4 + 2 * j, 6 + 2 * j, c * 8 + wv, G * 8); } }
        break; }
    case 12: if constexpr (KEN(12)) { pg8::Gemm g{(const bf16_t*)(ws + OFF_LORA), w_rw(P, j, 1), T, 6144, 256, 256, 256}; pg8::Order<3> So; So.init(T, 6144, G, c);
        EpiLoraUp E{in_ptr(P, 17) + (size_t)j * D, in_ptr(P, 20) + (size_t)j * D, (float*)(ws + OFF_DEC)}; pg8::gemm_phase(lds, g, So, E); break; }
    case 13: if constexpr (KEN(13)) phase_recur((const bf16_t*)(ws + OFF_R), (const bf16_t*)(ws + OFF_K), (const bf16_t*)(ws + OFF_V), (const float*)(ws + OFF_DEC), (const float*)(ws + OFF_AA),
                         in_ptr(P, 25) + (size_t)j * D, in_ptr(P, 26) + (size_t)j * D, in_ptr(P, 27) + (size_t)j * D, (float*)(ws + OFF_BON), (float*)(ws + OFF_YREC), lds); break;
    case 14: if constexpr (KEN(14)) phase_gn((const float*)(ws + OFF_YREC), (const bf16_t*)(ws + OFF_V), (const bf16_t*)(ws + OFF_GG), (const float*)(ws + OFF_BON),
                      in_ptr(P, 28) + (size_t)j * D, in_ptr(P, 29) + (size_t)j * D, ACTA); break;
    default: break;
    }
}

#define XB_TMO      128
#define XB_XCNT(j)  (256  + 64 * (j))
#define XB_XSUB(j)  (1280 + 64 * (j))
#define XB_XGEN(j)  (2304 + 64 * (j))
#define XB_TOP      3328
#define XB_TOPGEN   3392
#define XCD_BAR_WORDS 3456
#define XB_SPIN_CAP (1u << 20)
__device__ __forceinline__ unsigned xb_ld(unsigned* p)              { return __hip_atomic_load(p, __ATOMIC_RELAXED, __HIP_MEMORY_SCOPE_AGENT); }
__device__ __forceinline__ unsigned xb_add(unsigned* p, unsigned v) { return __hip_atomic_fetch_add(p, v, __ATOMIC_RELAXED, __HIP_MEMORY_SCOPE_AGENT); }
__device__ __forceinline__ unsigned xb_xcc_id() { return (unsigned)__builtin_amdgcn_s_getreg((3 << 11) | 20) & 0xFu; }
#define XB_SPIN(cond, bar) do { unsigned _sp = 0; while (cond) { __builtin_amdgcn_s_sleep(1); \
    if ((++_sp & 255u) == 0u) { if (xb_ld(&(bar)[XB_TMO])) break; if (_sp > XB_SPIN_CAP) { atomicAdd(&(bar)[XB_TMO], 1u); break; } } } } while (0)
struct XcdBarrier { unsigned* bar; unsigned x; volatile LAS unsigned* st; };
__device__ __forceinline__ XcdBarrier xcd_barrier_post(unsigned* bar, volatile LAS unsigned* st) {
    XcdBarrier b; b.bar = bar; b.x = xb_xcc_id(); b.st = st;
    if (threadIdx.x == 0) (void)xb_add(&bar[XB_XCNT(b.x)], 1u);
    return b;
}
__device__ __forceinline__ void xcd_barrier_complete(unsigned* bar, unsigned x, unsigned& nloc, unsigned& nx) {
    const unsigned G = gridDim.x * gridDim.y * gridDim.z;
    unsigned sum, cnt, mine, sp = 0u;
    for (;;) {
        sum = 0u; cnt = 0u; mine = 0u;
#pragma unroll
        for (unsigned j = 0; j < 16; ++j) { const unsigned c = xb_ld(&bar[XB_XCNT(j)]); sum += c; cnt += (c > 0u) ? 1u : 0u; mine = (j == x) ? c : mine; }
        if (sum == G) break;
        __builtin_amdgcn_s_sleep(1);
        if ((++sp & 255u) == 0u) { if (xb_ld(&bar[XB_TMO])) break; if (sp > XB_SPIN_CAP) { atomicAdd(&bar[XB_TMO], 1u); break; } }
    }
    nloc = mine > 0u ? mine : 1u; nx = cnt > 0u ? cnt : 1u;
}
__device__ __forceinline__ void xcd_barrier(const XcdBarrier& b) {
    asm volatile("s_waitcnt vmcnt(0)" ::: "memory");
    __syncthreads();
    if (threadIdx.x == 0) {
        unsigned* bar = b.bar;
        __builtin_amdgcn_s_waitcnt(0);
        unsigned nloc = b.st[0], nx = b.st[1];
        if (nloc == 0u) { xcd_barrier_complete(bar, b.x, nloc, nx); b.st[0] = nloc; b.st[1] = nx; }
        const unsigned old = xb_add(&bar[XB_XSUB(b.x)], 1u);
        const unsigned gen = old / nloc;
        if (old + 1u == (gen + 1u) * nloc) {
            __builtin_amdgcn_fence(__ATOMIC_RELEASE, "agent");
            asm volatile("s_waitcnt vmcnt(0)" ::: "memory");
            const unsigned og = xb_add(&bar[XB_TOP], 1u);
            const unsigned tg = og / nx;
            if (og + 1u == (tg + 1u) * nx) xb_add(&bar[XB_TOPGEN], 1u);
            else XB_SPIN(xb_ld(&bar[XB_TOPGEN]) == tg, bar);
            __builtin_amdgcn_fence(__ATOMIC_ACQUIRE, "agent");
            xb_add(&bar[XB_XGEN(b.x)], 1u);
            asm volatile("s_waitcnt vmcnt(0)" ::: "memory");
        } else {
            XB_SPIN(xb_ld(&bar[XB_XGEN(b.x)]) == gen, bar);
            __builtin_amdgcn_fence(__ATOMIC_ACQUIRE, "agent");
            asm volatile("s_waitcnt vmcnt(0)" ::: "memory");
        }
    }
    __syncthreads();
}

constexpr int N_PHASES = 40;

__global__ void __launch_bounds__(512, 2) mega(Params P) {
    extern __shared__ __attribute__((aligned(16))) unsigned char shm[];
    LAS unsigned char* lds = (LAS unsigned char*)shm;
    cg::grid_group grid = cg::this_grid();
    volatile LAS unsigned* st = (volatile LAS unsigned*)(lds + LDS_ST_OFF);
    if (threadIdx.x == 0) { st[0] = 0u; st[1] = 0u; }
    __syncthreads();
    const XcdBarrier xb = xcd_barrier_post((unsigned*)(P.ws + OFF_BAR), st);
    bool first_seam = true;
    for (int ph = P.ph_lo; ph < P.ph_hi; ++ph) {
        if (ph == 1) continue;
        int nrep = 1;
        if (REPMASK != 0u) {
            int kind; if (ph == 0) kind = 20; else if (ph == 39) kind = 21; else { const int r = (ph - 1) % 19; kind = r < 10 ? r : (r - 10 < 5 ? r : r - 9); }
            if ((REPMASK >> kind) & 1u) nrep = 2;
        }
        for (int rep = 0; rep < nrep; ++rep) {
            if (ph > P.ph_lo || rep > 0) {
                if (first_seam) { grid.sync(); first_seam = false; }
                else xcd_barrier(xb);
            }
            run_phase(P, ph, lds);
        }
    }
}

extern "C" void kernel_launch(void* const* d_in, const int* in_sizes, int n_in, void* d_out, int out_size, void* d_ws, size_t ws_size, hipStream_t stream) {
    static int grid = 0;
    if (grid == 0) {
        if (n_in != 31 || in_sizes[0] != T * D || out_size != T * D || ws_size < WS_END) {
            fprintf(stderr, "kernel_launch: unexpected shapes: n_in %d in0 %d out %d ws %zu (need %zu)\n", n_in, n_in > 0 ? in_sizes[0] : -1, out_size, ws_size, (size_t)WS_END); grid = -1; return; }
        int dev = 0, cus = 0, per_cu = 0;
        hipGetDevice(&dev); hipDeviceGetAttribute(&cus, hipDeviceAttributeMultiprocessorCount, dev);
        if (hipFuncSetAttribute((const void*)mega, hipFuncAttributeMaxDynamicSharedMemorySize, LDS_BYTES) != hipSuccess) { fprintf(stderr, "kernel_launch: hipFuncSetAttribute failed\n"); grid = -1; return; }
        if (hipOccupancyMaxActiveBlocksPerMultiprocessor(&per_cu, (const void*)mega, 512, LDS_BYTES) != hipSuccess || per_cu < 1) { fprintf(stderr, "kernel_launch: occupancy query says %d\n", per_cu); per_cu = 1; }
        (void)hipGetLastError();
        grid = cus * per_cu;
    }
    if (grid < 0) return;
    Params p{};
    for (int i = 0; i < 31; ++i) p.in[i] = (const float*)d_in[i];
    p.out = (float*)d_out; p.ws = (unsigned char*)d_ws;
    if (hipMemsetAsync((char*)d_ws + OFF_BAR, 0, XCD_BAR_WORDS * 4, stream) != hipSuccess) { fprintf(stderr, "kernel_launch: memset of the barrier words failed\n"); return; }
#if N_LAUNCH_PER_PHASE
    for (int ph = 0; ph < N_PHASES; ++ph) { p.ph_lo = ph; p.ph_hi = ph + 1; hipLaunchKernelGGL(mega, dim3(grid), dim3(512), LDS_BYTES, stream, p); }
#else
    p.ph_lo = 0; p.ph_hi = N_PHASES;
    void* args[] = {&p};
    hipError_t e = hipLaunchCooperativeKernel((const void*)mega, dim3(grid), dim3(512), args, LDS_BYTES, stream);
    if (e != hipSuccess) fprintf(stderr, "cooperative launch failed: %s (grid %d)\n", hipGetErrorString(e), grid);
#endif
}
```

```cpp
#include <hip/hip_runtime.h>
#include <hip/hip_cooperative_groups.h>
#include <cstdio>
#include <cstdint>
namespace cg = cooperative_groups;

#ifndef N_LAUNCH_PER_PHASE
#define N_LAUNCH_PER_PHASE 0
#endif

#ifndef KMASK
#define KMASK 0xffffffu
#endif
#define KEN(n) (((KMASK) >> (n)) & 1u)
#ifndef REPMASK
#define REPMASK 0u
#endif
#define LAS __attribute__((address_space(3)))
typedef unsigned short bf16_t;
typedef short bf16x8 __attribute__((ext_vector_type(8)));
typedef float f32x4 __attribute__((ext_vector_type(4)));
typedef float f32x2 __attribute__((ext_vector_type(2)));
typedef unsigned u32x2 __attribute__((ext_vector_type(2)));
typedef unsigned u32x4 __attribute__((ext_vector_type(4)));

constexpr int T = 8192, D = 2048, S = 4096, FF = 8192;
constexpr size_t MiB = 1ull << 20;
constexpr size_t TD = (size_t)T * D;
constexpr size_t SZ_W_RG = 26 * MiB;
constexpr size_t SZ_W_RW = 38 * MiB;
constexpr size_t SZ_W_MLP = 64 * MiB;
constexpr size_t OFF_W_RG = 0;
constexpr size_t OFF_W_RW = OFF_W_RG + 2 * SZ_W_RG;
constexpr size_t OFF_W_MLP = OFF_W_RW + 2 * SZ_W_RW;
constexpr size_t OFF_H = OFF_W_MLP + 4 * SZ_W_MLP;
constexpr size_t OFF_ACTA = OFF_H + 64 * MiB;
constexpr size_t OFF_X = OFF_ACTA + 32 * MiB;
constexpr size_t OFF_XM = OFF_X;
constexpr size_t OFF_DEC = OFF_X, OFF_AA = OFF_X + 64 * MiB, OFF_GG = OFF_X + 128 * MiB;
constexpr size_t OFF_R = OFF_X + 192 * MiB, OFF_K = OFF_R + 64 * MiB, OFF_V = OFF_K + 64 * MiB;
constexpr size_t OFF_LORA = OFF_X + 384 * MiB;
constexpr size_t OFF_YREC = OFF_X + 396 * MiB;
constexpr size_t OFF_GATE = OFF_X, OFF_REC = OFF_X + 64 * MiB, OFF_CV = OFF_X + 128 * MiB, OFF_CVB = OFF_X + 192 * MiB;
constexpr size_t OFF_AT = OFF_X + 224 * MiB, OFF_BT = OFF_X + 288 * MiB, OFF_AGGA = OFF_X + 352 * MiB, OFF_AGGH = OFF_X + 353 * MiB;
constexpr size_t OFF_U = OFF_X;
constexpr size_t OFF_H2 = OFF_X + 460 * MiB;
constexpr size_t OFF_BAR = OFF_H2 + 64 * MiB;
constexpr size_t OFF_BON = OFF_BAR + 1 * MiB;
constexpr size_t WS_END = OFF_BON + 1 * MiB;

constexpr int LDS_ST_OFF = 151552;
constexpr int LDS_BYTES = LDS_ST_OFF + 64;

struct Params {
    const float* in[31];
    float* out;
    unsigned char* ws;
    int ph_lo, ph_hi;
};

__device__ __forceinline__ const float* in_ptr(const Params& P, int i) { asm volatile("" : "+s"(i)); return P.in[i]; }
__device__ __forceinline__ unsigned cvt_pk_bf16(float lo, float hi) { unsigned r; asm volatile("v_cvt_pk_bf16_f32 %0, %1, %2" : "=v"(r) : "v"(lo), "v"(hi)); return r; }
__device__ __forceinline__ u32x2 pack4(f32x4 v) { u32x2 o; o.x = cvt_pk_bf16(v.x, v.y); o.y = cvt_pk_bf16(v.z, v.w); return o; }
__device__ __forceinline__ f32x4 unpack4(u32x2 u) { f32x4 o; o.x = __uint_as_float(u.x << 16); o.y = __uint_as_float(u.x & 0xffff0000u); o.z = __uint_as_float(u.y << 16); o.w = __uint_as_float(u.y & 0xffff0000u); return o; }
__device__ __forceinline__ void unpack8(u32x4 u, f32x4& a, f32x4& b) { a = unpack4((u32x2){u.x, u.y}); b = unpack4((u32x2){u.z, u.w}); }
__device__ __forceinline__ float wave_sum(float v) {
#pragma unroll
    for (int o = 1; o < 64; o <<= 1) v += __shfl_xor(v, o);
    return v;
}
__device__ __forceinline__ float sigmoidf_(float x) { return __builtin_amdgcn_rcpf(1.f + __expf(-x)); }
__device__ __forceinline__ float tanhf_(float x) { const float xc = fminf(fmaxf(x, -15.f), 15.f); return 1.f - 2.f * __builtin_amdgcn_rcpf(1.f + __expf(2.f * xc)); }
__device__ __forceinline__ float gelu_tanh(float x) { const float u = 0.7978845608028654f * (x + 0.044715f * x * x * x); return 0.5f * x * (1.f + tanhf_(u)); }
__device__ __forceinline__ float neg_expm1(float x) { return (fabsf(x) < 0.02f) ? -x * (1.f + x * (0.5f + x * (0.16666667f + x * 0.041666668f))) : 1.f - __expf(x); }
__device__ __forceinline__ int otid() { int t; asm volatile("v_mov_b32 %0, %1" : "=v"(t) : "v"((int)threadIdx.x)); return t; }
__device__ __forceinline__ int obid() { int t; asm volatile("s_mov_b32 %0, %1" : "=s"(t) : "s"((int)blockIdx.x)); return t; }
template <int CTRL> __device__ __forceinline__ float dpp_f(float v) { return __builtin_bit_cast(float, __builtin_amdgcn_update_dpp(0, __builtin_bit_cast(int, v), CTRL, 0xf, 0xf, false)); }
__device__ __forceinline__ float row16_allsum(float p) {
    p += dpp_f<0x128>(p); p += dpp_f<0x124>(p); p += dpp_f<0x122>(p); p += dpp_f<0x121>(p); return p;
}

namespace pg8 {
constexpr int BM = 256, BK = 64, HALF = 128, HTB = HALF * BK * 2, STAGE_BYTES = 8 * HTB, NXCD = 8, WGM = 8;
__host__ __device__ __forceinline__ int lds_byte(int r, int c) { const int st = (r >> 4) * 2 + (c >> 5), rr = r & 15, cc = c & 31, ob = rr * 64 + cc * 2; return st * 1024 + (ob ^ (((ob >> 9) & 1) << 5)); }
__host__ __device__ __forceinline__ void stage_rc(int b, int& R, int& C) { const int st = b / 1024, sb = b % 1024, swz = sb ^ (((sb >> 9) & 1) << 5); R = (st >> 1) * 16 + swz / 64; C = (st & 1) * 32 + (swz % 64) / 2; }
__host__ __device__ __forceinline__ int perm32(int rho) { const int n = rho >> 4, i = rho & 15; return 8 * (i >> 2) + 4 * n + (i & 3); }
struct Unit { int pm, pn; };
struct Gemm { const bf16_t* A; const bf16_t* Bt; int M, N, K, lda, ldb; };
template <int AMODE> struct Order {
    int nM, nN, nwg, G, c;
    __device__ void init(int M, int N, int G_, int c_) { nM = M / BM; nN = N / BM; nwg = nM * nN; G = G_; c = c_; }
    __device__ bool next(int i, Unit& u) const {
        const long L = (long)i * G + c; if (L >= nwg) return false;
        int wgid = (int)L; { const int q = nwg / NXCD, r = nwg % NXCD, xcd = wgid % NXCD, off = wgid / NXCD; wgid = (xcd < r ? xcd * (q + 1) : r * (q + 1) + (xcd - r) * q) + off; }
        const int nig = WGM * nN, gid = wgid / nig, fm = gid * WGM, gsz = (nM - fm) < WGM ? (nM - fm) : WGM;
        u.pm = fm + ((wgid % nig) % gsz); u.pn = (wgid % nig) / gsz; return true;
    }
    __device__ __forceinline__ size_t a_off(const Unit& u) const {
        if (AMODE == 1) return (size_t)(u.pn >> 1) * 512;
        if (AMODE == 2) { const int w = u.pn < 24 ? (u.pn >> 3) : (u.pn - 21); return (size_t)w * TD * 2; }
        if (AMODE == 3) return (size_t)(u.pn >> 3) * ((size_t)T * 256 * 2);
        return 0;
    }
};

#ifndef PG8_SP2
#define PG8_SP2 true
#endif
#ifndef PG8_ALIGN
#define PG8_ALIGN true
#endif
template <class Epi, class Sched, bool ALIGN_EPI = PG8_ALIGN, bool SP2 = PG8_SP2>
__device__ __forceinline__ void gemm_phase(LAS unsigned char* lds, const Gemm g, const Sched& S, const Epi& E) {
    int tid; asm volatile("v_mov_b32 %0, %1" : "=v"(tid) : "v"((int)threadIdx.x));
    const int wid = __builtin_amdgcn_readfirstlane(tid >> 6), lane = tid & 63, wr = wid >> 2, wc = wid & 3, fr = lane & 15, fq = lane >> 4;
    const int K = g.K, nt = K / BK;
    unsigned voffA[2], voffB[2];
#pragma unroll
    for (int i = 0; i < 2; ++i) { int R, C; stage_rc(tid * 16 + i * 8192, R, C);
        const int Rb = Epi::PERM ? ((R & ~31) + perm32(R & 31)) : R;
        voffA[i] = (unsigned)(R * g.lda + C) * 2u; voffB[i] = (unsigned)(Rb * g.ldb + C) * 2u; }
    const size_t kstep = (size_t)(BK * 2);
    const size_t hstepA = (size_t)HALF * g.lda * 2, hstepB = (size_t)HALF * g.ldb * 2;
    const size_t tstepA = 2 * hstepA, tstepB = 2 * hstepB;
    const unsigned ldsw = (unsigned)wid * 1024u;
    const int aoff = lds_byte(wr * 64 + fr, fq * 8), boff = lds_byte(wc * 32 + fr, fq * 8);
#define PG8_SA(b, h) (((b) * 2 + (h)) * HTB)
#define PG8_SB(b, h) ((4 + (b) * 2 + (h)) * HTB)
#define PG8_STAGE(bufoff, gbase, voff) do { _Pragma("unroll") for (int _i = 0; _i < 2; ++_i) \
        __builtin_amdgcn_global_load_lds((const unsigned*)((const char*)(gbase) + (voff)[_i]), (LAS unsigned*)(lds + (bufoff) + ldsw + _i * 8192), 16, 0, 0); } while (0)
#define PG8_LDA(dst, b, h) do { _Pragma("unroll") for (int m = 0; m < 4; ++m) _Pragma("unroll") for (int k = 0; k < 2; ++k) dst[m][k] = *(const LAS bf16x8*)(lds + PG8_SA(b, h) + aoff + m * 2048 + k * 1024); } while (0)
#define PG8_LDB(dst, b, h) do { _Pragma("unroll") for (int n = 0; n < 2; ++n) _Pragma("unroll") for (int k = 0; k < 2; ++k) dst[n][k] = *(const LAS bf16x8*)(lds + PG8_SB(b, h) + boff + n * 2048 + k * 1024); } while (0)
#define PG8_MMA(ai, bj, At, Bt) do { __builtin_amdgcn_s_setprio(1); _Pragma("unroll") for (int m = 0; m < 4; ++m) _Pragma("unroll") for (int n = 0; n < 2; ++n) _Pragma("unroll") for (int k = 0; k < 2; ++k) \
        acc[ai][bj][m][n] = __builtin_amdgcn_mfma_f32_16x16x32_bf16(Bt[n][k], At[m][k], acc[ai][bj][m][n], 0, 0, 0); __builtin_amdgcn_s_setprio(0); } while (0)
#define PG8_WAIT_V(n) asm volatile("s_waitcnt vmcnt(" #n ")" ::: "memory")
#define PG8_WAIT_L(n) asm volatile("s_waitcnt lgkmcnt(" #n ")" ::: "memory")
#define PG8_BAR __builtin_amdgcn_s_barrier()
#define PG8_SCHED __builtin_amdgcn_sched_barrier(0)
    Unit cur, nxt; int ui = 0;
    if (!S.next(0, cur)) return;
    f32x4 acc[2][2][4][2];
#pragma unroll
    for (int a = 0; a < 2; ++a)
#pragma unroll
        for (int b = 0; b < 2; ++b)
#pragma unroll
            for (int m = 0; m < 4; ++m)
#pragma unroll
                for (int n = 0; n < 2; ++n) acc[a][b][m][n] = (f32x4){0.f, 0.f, 0.f, 0.f};
    bf16x8 At[4][2], B0[2][2], B1[2][2];
    const char* cA = (const char*)g.A + (size_t)cur.pm * tstepA + S.a_off(cur); const char* cB = (const char*)g.Bt + (size_t)cur.pn * tstepB;
    if constexpr (SP2) {
        PG8_STAGE(PG8_SB(0, 0), cB, voffB); PG8_STAGE(PG8_SB(0, 1), cB + hstepB, voffB); PG8_STAGE(PG8_SA(0, 0), cA, voffA); PG8_STAGE(PG8_SA(0, 1), cA + hstepA, voffA);
        if (wr == 1) PG8_BAR;
        PG8_WAIT_V(2); PG8_BAR;
        PG8_STAGE(PG8_SB(1, 0), cB + kstep, voffB); PG8_STAGE(PG8_SA(1, 0), cA + kstep, voffA); PG8_STAGE(PG8_SB(1, 1), cB + hstepB + kstep, voffB);
        PG8_WAIT_V(6); PG8_BAR;
    } else {
        PG8_STAGE(PG8_SB(0, 0), cB, voffB); PG8_STAGE(PG8_SA(0, 0), cA, voffA); PG8_STAGE(PG8_SB(0, 1), cB + hstepB, voffB); PG8_STAGE(PG8_SA(0, 1), cA + hstepA, voffA);
        if (wr == 1) PG8_BAR;
        PG8_WAIT_V(4); PG8_BAR;
        PG8_STAGE(PG8_SB(1, 0), cB + kstep, voffB); PG8_STAGE(PG8_SA(1, 0), cA + kstep, voffA); PG8_STAGE(PG8_SB(1, 1), cB + hstepB + kstep, voffB);
        PG8_WAIT_V(6); PG8_BAR;
    }
    for (;;) {
        const bool has_next = S.next(ui + 1, nxt);
        const char* nA = has_next ? (const char*)g.A + (size_t)nxt.pm * tstepA + S.a_off(nxt) : cA; const char* nB = has_next ? (const char*)g.Bt + (size_t)nxt.pn * tstepB : cB;
#pragma unroll 1
        for (int t = 0; t < nt; t += 2) {
            const bool last = (t == nt - 2);
            const char* a1 = cA + (size_t)(t + 1) * kstep;
            const char* a2 = last ? nA : cA + (size_t)(t + 2) * kstep; const char* b2 = last ? nB : cB + (size_t)(t + 2) * kstep;
            const char* a3 = a2 + kstep; const char* b3 = b2 + kstep;
            if constexpr (SP2) {
            PG8_LDB(B0, 0, 0); PG8_LDB(B1, 0, 1); PG8_SCHED; PG8_LDA(At, 0, 0); PG8_STAGE(PG8_SA(1, 1), a1 + hstepA, voffA);
            PG8_WAIT_V(8); PG8_WAIT_L(0); PG8_BAR; PG8_MMA(0, 0, At, B0); PG8_MMA(0, 1, At, B1); PG8_BAR; PG8_SCHED;
            PG8_LDA(At, 0, 1); PG8_STAGE(PG8_SB(0, 0), b2, voffB); PG8_STAGE(PG8_SB(0, 1), b2 + hstepB, voffB); PG8_STAGE(PG8_SA(0, 0), a2, voffA);
            PG8_WAIT_V(8); PG8_WAIT_L(0); PG8_BAR; PG8_MMA(1, 0, At, B0); PG8_MMA(1, 1, At, B1); PG8_BAR; PG8_SCHED;
            PG8_LDB(B0, 1, 0); PG8_LDB(B1, 1, 1); PG8_SCHED; PG8_LDA(At, 1, 0); PG8_STAGE(PG8_SA(0, 1), a2 + hstepA, voffA);
            PG8_WAIT_V(8); PG8_WAIT_L(0); PG8_BAR; PG8_MMA(0, 0, At, B0); PG8_MMA(0, 1, At, B1); PG8_BAR; PG8_SCHED;
            PG8_LDA(At, 1, 1); PG8_STAGE(PG8_SB(1, 0), b3, voffB); PG8_STAGE(PG8_SB(1, 1), b3 + hstepB, voffB); PG8_STAGE(PG8_SA(1, 0), a3, voffA);
            PG8_WAIT_V(8); PG8_WAIT_L(0); PG8_BAR; PG8_MMA(1, 0, At, B0); PG8_MMA(1, 1, At, B1); PG8_BAR; PG8_SCHED;
            } else {
            PG8_LDB(B0, 0, 0); PG8_SCHED; PG8_LDA(At, 0, 0); PG8_STAGE(PG8_SA(1, 1), a1 + hstepA, voffA);
            PG8_WAIT_L(8); PG8_BAR; PG8_WAIT_L(0); PG8_MMA(0, 0, At, B0); PG8_BAR; PG8_SCHED;
            PG8_LDB(B1, 0, 1); PG8_STAGE(PG8_SB(0, 0), b2, voffB);
            PG8_BAR; PG8_WAIT_L(0); PG8_MMA(0, 1, At, B1); PG8_BAR;
            PG8_LDA(At, 0, 1); PG8_STAGE(PG8_SA(0, 0), a2, voffA);
            PG8_BAR; PG8_WAIT_L(0); PG8_MMA(1, 0, At, B0); PG8_BAR; PG8_SCHED;
            PG8_STAGE(PG8_SB(0, 1), b2 + hstepB, voffB);
            PG8_WAIT_V(6); PG8_BAR; PG8_MMA(1, 1, At, B1); PG8_BAR;
            PG8_LDB(B0, 1, 0); PG8_SCHED; PG8_LDA(At, 1, 0); PG8_STAGE(PG8_SA(0, 1), a2 + hstepA, voffA);
            PG8_WAIT_L(8); PG8_BAR; PG8_WAIT_L(0); PG8_MMA(0, 0, At, B0); PG8_BAR; PG8_SCHED;
            PG8_LDB(B1, 1, 1); PG8_STAGE(PG8_SB(1, 0), b3, voffB);
            PG8_BAR; PG8_WAIT_L(0); PG8_MMA(0, 1, At, B1); PG8_BAR;
            PG8_LDA(At, 1, 1); PG8_STAGE(PG8_SA(1, 0), a3, voffA);
            PG8_BAR; PG8_WAIT_L(0); PG8_MMA(1, 0, At, B0); PG8_BAR; PG8_SCHED;
            PG8_STAGE(PG8_SB(1, 1), b3 + hstepB, voffB);
            PG8_WAIT_V(6); PG8_BAR; PG8_MMA(1, 1, At, B1); PG8_BAR;
                    }
        }
        if constexpr (ALIGN_EPI) { if (wr == 0) PG8_BAR; }
        E(acc, cur, wr, wc, fr, fq);
        if (!has_next) break;
#pragma unroll
        for (int a = 0; a < 2; ++a)
#pragma unroll
            for (int b = 0; b < 2; ++b)
#pragma unroll
                for (int m = 0; m < 4; ++m)
#pragma unroll
                    for (int n = 0; n < 2; ++n) acc[a][b][m][n] = (f32x4){0.f, 0.f, 0.f, 0.f};
        cur = nxt; cA = nA; cB = nB; ++ui;
        if constexpr (ALIGN_EPI) { if (wr == 1) PG8_BAR; }
    }
    PG8_WAIT_V(0);
    if constexpr (!ALIGN_EPI) { if (wr == 0) PG8_BAR; }
    PG8_BAR;
#undef PG8_SA
#undef PG8_SB
#undef PG8_STAGE
#undef PG8_LDA
#undef PG8_LDB
#undef PG8_MMA
#undef PG8_WAIT_V
#undef PG8_WAIT_L
#undef PG8_BAR
#undef PG8_SCHED
}
}
using pg8::Unit;
typedef f32x4 Acc[2][2][4][2];
__device__ __forceinline__ u32x4 pack8(f32x4 a, f32x4 b) { u32x4 o; o.x = cvt_pk_bf16(a.x, a.y); o.y = cvt_pk_bf16(a.z, a.w); o.z = cvt_pk_bf16(b.x, b.y); o.w = cvt_pk_bf16(b.z, b.w); return o; }

struct EpiResidual {
    static constexpr bool PERM = true;
    const float* src; float* out;
    __device__ __forceinline__ void operator()(const Acc& acc, const Unit& u, int wr, int wc, int fr, int fq) const {
        const int row0 = u.pm * 256 + wr * 64 + fr, col0 = u.pn * 256 + wc * 32 + 8 * fq;
#pragma unroll
        for (int ai = 0; ai < 2; ++ai)
#pragma unroll
            for (int m = 0; m < 4; ++m) { const size_t ro = (size_t)(row0 + ai * 128 + m * 16) * D + col0;
#pragma unroll
                for (int bj = 0; bj < 2; ++bj) { const size_t o = ro + bj * 128;
                    const f32x4 h0 = *(const f32x4*)(src + o) + acc[ai][bj][m][0], h1 = *(const f32x4*)(src + o + 4) + acc[ai][bj][m][1];
                    *(f32x4*)(out + o) = h0; *(f32x4*)(out + o + 4) = h1; } }
    }
};
struct EpiInProj {
    static constexpr bool PERM = true;
    bf16_t* gate; bf16_t* rec;
    __device__ __forceinline__ void operator()(const Acc& acc, const Unit& u, int wr, int wc, int fr, int fq) const {
        const bool isg = u.pn < 8; bf16_t* dst = isg ? gate : rec;
        const int row0 = u.pm * 256 + wr * 64 + fr, col0 = (u.pn & 7) * 256 + wc * 32 + 8 * fq;
#pragma unroll
        for (int ai = 0; ai < 2; ++ai)
#pragma unroll
            for (int m = 0; m < 4; ++m) { const size_t ro = (size_t)(row0 + ai * 128 + m * 16) * D + col0;
#pragma unroll
                for (int bj = 0; bj < 2; ++bj) { f32x4 v0 = acc[ai][bj][m][0], v1 = acc[ai][bj][m][1];
                    if (isg) {
#pragma unroll
                        for (int j = 0; j < 4; ++j) { v0[j] = gelu_tanh(v0[j]); v1[j] = gelu_tanh(v1[j]); } }
                    *(u32x4*)(dst + ro + bj * 128) = pack8(v0, v1); } }
    }
};
struct EpiGates {
    static constexpr bool PERM = true;
    const float* gxb; const float* gab; const float* lam; const bf16_t* cv; bf16_t* at; bf16_t* bt;
    __device__ __forceinline__ void operator()(const Acc& acc, const Unit& u, int wr, int wc, int fr, int fq) const {
        const int row0 = u.pm * 256 + wr * 64 + fr, ch0 = (u.pn >> 1) * 256 + (u.pn & 1) * 128 + wc * 32 + 8 * fq;
        u32x4 cvr[2][4];
#pragma unroll
        for (int ai = 0; ai < 2; ++ai)
#pragma unroll
            for (int m = 0; m < 4; ++m) cvr[ai][m] = *(const u32x4*)(cv + (size_t)(row0 + ai * 128 + m * 16) * D + ch0);
        f32x4 bx[2], ba[2], ls[2];
#pragma unroll
        for (int n = 0; n < 2; ++n) { bx[n] = *(const f32x4*)(gxb + ch0 + 4 * n); ba[n] = *(const f32x4*)(gab + ch0 + 4 * n); const f32x4 lm = *(const f32x4*)(lam + ch0 + 4 * n);
#pragma unroll
            for (int j = 0; j < 4; ++j) ls[n][j] = -8.f * ((lm[j] > 0.f) ? __logf(1.f + __expf(-lm[j])) : (-lm[j] + __logf(1.f + __expf(lm[j])))); }
#pragma unroll
        for (int ai = 0; ai < 2; ++ai)
#pragma unroll
            for (int m = 0; m < 4; ++m) { const size_t o = (size_t)(row0 + ai * 128 + m * 16) * D + ch0;
                f32x4 cvv[2]; unpack8(cvr[ai][m], cvv[0], cvv[1]); f32x4 av[2], bv[2];
#pragma unroll
                for (int n = 0; n < 2; ++n) { const f32x4 gi = acc[ai][0][m][n], gr = acc[ai][1][m][n];
#pragma unroll
                    for (int j = 0; j < 4; ++j) { const float it = sigmoidf_(gi[j] + bx[n][j]), rt = sigmoidf_(gr[j] + ba[n][j]);
                        const float la = rt * ls[n][j]; av[n][j] = la; bv[n][j] = __builtin_amdgcn_sqrtf(fmaxf(1.f - __expf(2.f * la), 0.f)) * (it * cvv[n][j]); } }
                *(u32x4*)(at + o) = pack8(av[0], av[1]); *(u32x4*)(bt + o) = pack8(bv[0], bv[1]); }
    }
};
struct EpiRKV {
    static constexpr bool PERM = true;
    unsigned char* rkv; bf16_t* lora;
    __device__ __forceinline__ void operator()(const Acc& acc, const Unit& u, int wr, int wc, int fr, int fq) const {
        const int row0 = u.pm * 256 + wr * 64 + fr;
        if (u.pn < 24) {
            bf16_t* dst = (bf16_t*)(rkv + (size_t)(u.pn >> 3) * (64 * MiB)); const int col0 = (u.pn & 7) * 256 + wc * 32 + 8 * fq;
#pragma unroll
            for (int ai = 0; ai < 2; ++ai)
#pragma unroll
                for (int m = 0; m < 4; ++m) { const size_t ro = (size_t)(row0 + ai * 128 + m * 16) * D + col0;
#pragma unroll
                    for (int bj = 0; bj < 2; ++bj) *(u32x4*)(dst + ro + bj * 128) = pack8(acc[ai][bj][m][0], acc[ai][bj][m][1]); }
        } else {
            const int w = u.pn - 24; bf16_t* dst = lora + (size_t)w * T * 256; const int col0 = wc * 32 + 8 * fq;
#pragma unroll
            for (int ai = 0; ai < 2; ++ai)
#pragma unroll
                for (int m = 0; m < 4; ++m) { const size_t ro = (size_t)(row0 + ai * 128 + m * 16) * 256 + col0;
#pragma unroll
                    for (int bj = 0; bj < 2; ++bj) { f32x4 v0 = acc[ai][bj][m][0], v1 = acc[ai][bj][m][1];
                        if (w == 0) {
#pragma unroll
                            for (int j = 0; j < 4; ++j) { v0[j] = tanhf_(v0[j]); v1[j] = tanhf_(v1[j]); }
                        } else if (w == 2) {
#pragma unroll
                            for (int j = 0; j < 4; ++j) { v0[j] = sigmoidf_(v0[j]); v1[j] = sigmoidf_(v1[j]); } }
                        *(u32x4*)(dst + ro + bj * 128) = pack8(v0, v1); } }
        }
    }
};
struct EpiLoraUp {
    static constexpr bool PERM = true;
    const float* w0; const float* a0; float* dec;
    __device__ __forceinline__ void operator()(const Acc& acc, const Unit& u, int wr, int wc, int fr, int fq) const {
        const int w = u.pn >> 3; float* dst = dec + (size_t)w * TD; const float* bias = (w == 0) ? w0 : a0;
        const int row0 = u.pm * 256 + wr * 64 + fr, col0 = (u.pn & 7) * 256 + wc * 32 + 8 * fq;
#pragma unroll
        for (int bj = 0; bj < 2; ++bj) { const int c = col0 + bj * 128; const f32x4 bb0 = *(const f32x4*)(bias + c), bb1 = *(const f32x4*)(bias + c + 4);
#pragma unroll
            for (int ai = 0; ai < 2; ++ai)
#pragma unroll
                for (int m = 0; m < 4; ++m) { f32x4 v0 = acc[ai][bj][m][0], v1 = acc[ai][bj][m][1]; const size_t o = (size_t)(row0 + ai * 128 + m * 16) * D + c;
                    if (w == 0) {
#pragma unroll
                        for (int j = 0; j < 4; ++j) { v0[j] = __expf(-0.6065306597126334f * sigmoidf_(v0[j] + bb0[j])); v1[j] = __expf(-0.6065306597126334f * sigmoidf_(v1[j] + bb1[j])); }
                    } else if (w == 1) {
#pragma unroll
                        for (int j = 0; j < 4; ++j) { v0[j] = sigmoidf_(v0[j] + bb0[j]); v1[j] = sigmoidf_(v1[j] + bb1[j]); }
                    }
                    if (w == 2) *(u32x4*)((bf16_t*)dst + o) = pack8(v0, v1);
                    else { *(f32x4*)(dst + o) = v0; *(f32x4*)(dst + o + 4) = v1; } } }
    }
};
struct EpiUp {
    static constexpr bool PERM = true;
    bf16_t* U;
    __device__ __forceinline__ void operator()(const Acc& acc, const Unit& u, int wr, int wc, int fr, int fq) const {
        const int row0 = u.pm * 256 + wr * 64 + fr, col0 = u.pn * 256 + wc * 32 + 8 * fq;
#pragma unroll
        for (int ai = 0; ai < 2; ++ai)
#pragma unroll
            for (int m = 0; m < 4; ++m) { const size_t ro = (size_t)(row0 + ai * 128 + m * 16) * FF + col0;
#pragma unroll
                for (int bj = 0; bj < 2; ++bj) { f32x4 v0 = acc[ai][bj][m][0], v1 = acc[ai][bj][m][1];
#pragma unroll
                    for (int j = 0; j < 4; ++j) { const float r0 = fmaxf(v0[j], 0.f), r1 = fmaxf(v1[j], 0.f); v0[j] = r0 * r0; v1[j] = r1 * r1; }
                    *(u32x4*)(U + ro + bj * 128) = pack8(v0, v1); } }
    }
};

__device__ __forceinline__ void tr_load(f32x4 (&r)[8], const float* W, int K, int N, int k0, int n0, int lane) {
#pragma unroll
    for (int i = 0; i < 8; ++i) { const int k = k0 + 8 * i + (lane >> 3); r[i] = (k < K) ? __builtin_nontemporal_load((const f32x4*)(W + (size_t)k * N + n0 + (lane & 7) * 4)) : (f32x4){0.f, 0.f, 0.f, 0.f}; }
}
__device__ __forceinline__ void tr_store(const f32x4 (&r)[8], bf16_t* WT, int ldt, int dst_k0, int dst_row0, LAS float* scr, int lane) {
#pragma unroll
    for (int i = 0; i < 8; ++i) { LAS float* d = scr + (8 * i + (lane >> 3)) * 33 + (lane & 7) * 4; d[0] = r[i].x; d[1] = r[i].y; d[2] = r[i].z; d[3] = r[i].w; }
    asm volatile("s_waitcnt lgkmcnt(0)" ::: "memory");
    const int c = lane & 7;
#pragma unroll
    for (int j = 0; j < 4; ++j) { const int n = (lane >> 3) + 8 * j; const LAS float* s = scr + (8 * c) * 33 + n;
        u32x4 o; o.x = cvt_pk_bf16(s[0 * 33], s[1 * 33]); o.y = cvt_pk_bf16(s[2 * 33], s[3 * 33]); o.z = cvt_pk_bf16(s[4 * 33], s[5 * 33]); o.w = cvt_pk_bf16(s[6 * 33], s[7 * 33]);
        *(u32x4*)(WT + (size_t)(dst_row0 + n) * ldt + dst_k0 + 8 * c) = o; }
    asm volatile("s_waitcnt lgkmcnt(0)" ::: "memory");
}

__device__ __forceinline__ bf16_t* w_rg(const Params& P, int j, int which) { return (bf16_t*)(P.ws + OFF_W_RG + (size_t)j * SZ_W_RG + (which == 0 ? 0 : which == 1 ? 16 * MiB : 18 * MiB)); }
__device__ __forceinline__ bf16_t* w_rw(const Params& P, int j, int which) { return (bf16_t*)(P.ws + OFF_W_RW + (size_t)j * SZ_W_RW + (which == 0 ? 0 : which == 1 ? 27 * MiB : 30 * MiB)); }
__device__ __forceinline__ bf16_t* w_mlp(const Params& P, int i, int which) { return (bf16_t*)(P.ws + OFF_W_MLP + (size_t)i * SZ_W_MLP + (which == 0 ? 0 : 32 * MiB)); }

struct JobD { const float* W; bf16_t* WT; int K, N, ldt, nnb, nit, mode, aux; };
constexpr int NJOBS = 36;
__device__ __forceinline__ void get_job(const Params& P, int jid, JobD& d) {
    int src, Kpad; size_t soff; d.mode = 0; d.aux = 0;
    if (jid < 8) { const int i = jid >> 1;
        if (!(jid & 1)) { src = 3; soff = (size_t)i * D * FF; d.K = D; d.N = FF; d.WT = w_mlp(P, i, 0); d.ldt = D; Kpad = D; }
        else { src = 4; soff = (size_t)i * FF * D; d.K = FF; d.N = D; d.WT = w_mlp(P, i, 1); d.ldt = FF; Kpad = FF; }
    } else if (jid < 16) { const int j = (jid - 8) >> 2, q = (jid - 8) & 3;
        if (q == 0) { src = 6; soff = (size_t)j * D * 2 * D; d.K = D; d.N = 2 * D; d.WT = w_rg(P, j, 0); d.ldt = D; Kpad = D; }
        else if (q == 1) { src = 14; soff = (size_t)j * D * D; d.K = D; d.N = D; d.WT = w_rg(P, j, 2); d.ldt = D; Kpad = D; }
        else { src = (q == 2) ? 9 : 11; soff = (size_t)j * 8 * 65536; d.K = 2048; d.N = 256; d.WT = w_rg(P, j, 1); d.ldt = 256; Kpad = 2048; d.mode = 1; d.aux = (q == 2) ? 0 : 128; }
    } else { const int j = (jid - 16) / 10, q = (jid - 16) % 10; d.K = D; d.N = D; d.ldt = D; Kpad = D; d.WT = w_rw(P, j, 0);
        if (q < 3) { src = 16; soff = (size_t)(j * 3 + q) * D * D; d.aux = q * D; }
        else if (q == 3) { src = 18; soff = (size_t)j * D * 96; d.N = 96; d.aux = 6144; }
        else if (q == 4) { src = 21; soff = (size_t)j * D * 96; d.N = 96; d.aux = 6144 + 256; }
        else if (q == 5) { src = 23; soff = (size_t)j * D * 256; d.N = 256; d.aux = 6144 + 512; }
        else if (q == 6) { src = 19; soff = (size_t)j * 96 * D; d.K = 96; d.WT = w_rw(P, j, 1); d.ldt = 256; Kpad = 256; }
        else if (q == 7) { src = 22; soff = (size_t)j * 96 * D; d.K = 96; d.WT = w_rw(P, j, 1); d.ldt = 256; Kpad = 256; d.aux = 2048; }
        else if (q == 8) { src = 24; soff = (size_t)j * 256 * D; d.K = 256; d.WT = w_rw(P, j, 1); d.ldt = 256; Kpad = 256; d.aux = 4096; }
        else { src = 30; soff = (size_t)j * D * D; d.WT = w_rw(P, j, 2); }
    }
    d.W = in_ptr(P, __builtin_amdgcn_readfirstlane(src)) + soff; d.nnb = d.N / 32; d.nit = (Kpad / 64) * d.nnb;
}
__device__ __forceinline__ void convert_jobs(const Params& P, LAS unsigned char* lds, int jlo, int jhi, int gw, int NGW) {
    const int tid = otid(), lane = tid & 63, wave = __builtin_amdgcn_readfirstlane(tid >> 6);
    LAS float* scr = (LAS float*)(lds + wave * 16384);
    int jid = jlo, it = gw; JobD cj; get_job(P, jid, cj);
    while (it >= cj.nit) { it -= cj.nit; if (++jid >= jhi) return; get_job(P, jid, cj); }
    f32x4 r[8]; tr_load(r, cj.W, cj.K, cj.N, (it / cj.nnb) * 64, (it % cj.nnb) * 32, lane);
    for (;;) {
        int njid = jid, nit_ = it + NGW; JobD nj = cj; bool have = true;
        while (nit_ >= nj.nit) { nit_ -= nj.nit; if (++njid >= jhi) { have = false; break; } get_job(P, njid, nj); }
        f32x4 rn[8];
        if (have) tr_load(rn, nj.W, nj.K, nj.N, (nit_ / nj.nnb) * 64, (nit_ % nj.nnb) * 32, lane);
        else {
#pragma unroll
            for (int q = 0; q < 8; ++q) rn[q] = (f32x4){0.f, 0.f, 0.f, 0.f};
        }
        const int k0 = (it / cj.nnb) * 64, n0 = (it % cj.nnb) * 32;
        const int drow = (cj.mode == 1) ? (((k0 >> 8) * 2 + (n0 >> 7)) * 256 + cj.aux + (n0 & 127)) : (cj.aux + n0);
        const int dk0 = (cj.mode == 1) ? (k0 & 255) : k0;
        tr_store(r, cj.WT, cj.ldt, dk0, drow, scr, lane);
        if (!have) break;
#pragma unroll
        for (int q = 0; q < 8; ++q) r[q] = rn[q];
        jid = njid; it = nit_; cj = nj;
    }
}
__device__ __forceinline__ void phase_convert(const Params& P, LAS unsigned char* lds) {
    const int tid = otid(), bid = obid(), wave = __builtin_amdgcn_readfirstlane(tid >> 6);
    const int gw = bid * 8 + wave, NGW = gridDim.x * 8;
    for (int j = 0; j < 2; ++j) {
        u32x4* z0 = (u32x4*)(w_rw(P, j, 0) + (size_t)(6144 + 96) * D); u32x4* z1 = (u32x4*)(w_rw(P, j, 0) + (size_t)(6144 + 256 + 96) * D);
        for (int i = bid * 512 + tid; i < 40960; i += gridDim.x * 512) { z0[i] = (u32x4){0u, 0u, 0u, 0u}; z1[i] = (u32x4){0u, 0u, 0u, 0u}; }
    }
    convert_jobs(P, lds, 0, 4, gw, NGW);
    convert_jobs(P, lds, 8, NJOBS, gw, NGW);
}

template <bool F32OUT> __device__ __forceinline__ void phase_norm(const float* __restrict__ src, const float* __restrict__ g, bf16_t* __restrict__ dstb, float* __restrict__ dstf) {
    const int tid = otid(), lane = tid & 63, gw = obid() * 8 + (tid >> 6), NGW = gridDim.x * 8;
    for (int row = gw; row < T; row += NGW) {
        const f32x4* xr = (const f32x4*)(src + (size_t)row * D) + 2 * lane;
        f32x4 v[8]; float s = 0.f;
#pragma unroll
        for (int j = 0; j < 4; ++j) { v[2 * j] = xr[128 * j]; v[2 * j + 1] = xr[128 * j + 1];
            s += (v[2 * j].x * v[2 * j].x + v[2 * j].y * v[2 * j].y) + (v[2 * j].z * v[2 * j].z + v[2 * j].w * v[2 * j].w);
            s += (v[2 * j + 1].x * v[2 * j + 1].x + v[2 * j + 1].y * v[2 * j + 1].y) + (v[2 * j + 1].z * v[2 * j + 1].z + v[2 * j + 1].w * v[2 * j + 1].w); }
        const float sc = 1.f / sqrtf(wave_sum(s) * (1.f / D) + 1e-6f);
#pragma unroll
        for (int j = 0; j < 4; ++j) { const int i4 = 128 * j + 2 * lane; const f32x4 o0 = v[2 * j] * sc * ((const f32x4*)g)[i4], o1 = v[2 * j + 1] * sc * ((const f32x4*)g)[i4 + 1];
            if (F32OUT) { __builtin_nontemporal_store(o0, (f32x4*)(dstf + (size_t)row * D) + i4); __builtin_nontemporal_store(o1, (f32x4*)(dstf + (size_t)row * D) + i4 + 1); }
            else ((u32x4*)(dstb + (size_t)row * D))[64 * j + lane] = pack8(o0, o1); }
    }
}

__device__ __forceinline__ void phase_mix(const float* __restrict__ src, const float* __restrict__ g, const float* __restrict__ mu, bf16_t* __restrict__ xm) {
    const int tid = otid(), lane = tid & 63, gw = obid() * 8 + (tid >> 6), NGW = gridDim.x * 8;
    for (int row = gw; row < T; row += NGW) {
        const bool hasp = (row % S) != 0;
        const f32x4* x2 = (const f32x4*)(src + (size_t)row * D) + 2 * lane; const f32x4* p2 = x2 - (D / 4);
        const f32x4 z4 = {0.f, 0.f, 0.f, 0.f};
        f32x4 v[8], p[8]; float s = 0.f, sp = 0.f;
#pragma unroll
        for (int j = 0; j < 4; ++j) { v[2 * j] = x2[128 * j]; v[2 * j + 1] = x2[128 * j + 1]; p[2 * j] = hasp ? p2[128 * j] : z4; p[2 * j + 1] = hasp ? p2[128 * j + 1] : z4; }
#pragma unroll
        for (int i = 0; i < 8; ++i) { s += (v[i].x * v[i].x + v[i].y * v[i].y) + (v[i].z * v[i].z + v[i].w * v[i].w); sp += (p[i].x * p[i].x + p[i].y * p[i].y) + (p[i].z * p[i].z + p[i].w * p[i].w); }
        const float sc = 1.f / sqrtf(wave_sum(s) * (1.f / D) + 1e-6f), scp = 1.f / sqrtf(wave_sum(sp) * (1.f / D) + 1e-6f);
#pragma unroll
        for (int j = 0; j < 4; ++j) { const int i4 = 128 * j + 2 * lane;
            const f32x4 g0 = ((const f32x4*)g)[i4], g1 = ((const f32x4*)g)[i4 + 1];
            const f32x4 hn0 = v[2 * j] * sc * g0, hn1 = v[2 * j + 1] * sc * g1, xx0 = p[2 * j] * scp * g0 - hn0, xx1 = p[2 * j + 1] * scp * g1 - hn1;
#pragma unroll
            for (int q = 0; q < 6; ++q) { const f32x4 m0 = ((const f32x4*)(mu + q * D))[i4], m1 = ((const f32x4*)(mu + q * D))[i4 + 1];
                ((u32x4*)(xm + (size_t)q * TD + (size_t)row * D))[64 * j + lane] = pack8(hn0 + xx0 * m0, hn1 + xx1 * m1); }
            __builtin_amdgcn_sched_barrier(0); }
    }
}

__device__ __forceinline__ void phase_conv(const bf16_t* __restrict__ rec, const float* __restrict__ cw, const float* __restrict__ cb, bf16_t* __restrict__ cvb) {
    const int n8 = T * (D / 8);
    for (int idx = obid() * 512 + otid(); idx < n8; idx += gridDim.x * 512) {
        const int row = idx / (D / 8), c8 = idx % (D / 8), t = row % S;
        f32x4 a0 = ((const f32x4*)cb)[2 * c8], a1 = ((const f32x4*)cb)[2 * c8 + 1];
#pragma unroll
        for (int k = 0; k < 4; ++k) { const int dt = 3 - k; if (t - dt >= 0) { f32x4 r0, r1; unpack8(((const u32x4*)(rec + (size_t)(row - dt) * D))[c8], r0, r1);
            a0 += ((const f32x4*)(cw + k * D))[2 * c8] * r0; a1 += ((const f32x4*)(cw + k * D))[2 * c8 + 1] * r1; } }
        ((u32x4*)cvb)[idx] = pack8(a0, a1);
    }
}

__device__ __forceinline__ void phase_scan1(const bf16_t* __restrict__ at, const bf16_t* __restrict__ bt, float* __restrict__ agga, float* __restrict__ aggh) {
    const int tid = otid();
    for (int item = obid(); item < 256; item += gridDim.x) {
        const int b = item >> 7, chunk = (item >> 1) & 63, half = item & 1, c = half * 1024 + 2 * tid;
        const size_t r0 = (size_t)(b * S + chunk * 64) * D + c;
        f32x2 hh = {0.f, 0.f}, pp = {1.f, 1.f};
#pragma unroll 16
        for (int t = 0; t < 64; ++t) { const size_t o = r0 + (size_t)t * D; const unsigned au = *(const unsigned*)(at + o), bu = *(const unsigned*)(bt + o);
            const f32x2 a2 = {__expf(__uint_as_float(au << 16)), __expf(__uint_as_float(au & 0xffff0000u))}, b2 = {__uint_as_float(bu << 16), __uint_as_float(bu & 0xffff0000u)};
            hh = a2 * hh + b2; pp = pp * a2; }
        const size_t ao = (size_t)(b * 64 + chunk) * D + c; *(f32x2*)(agga + ao) = pp; *(f32x2*)(aggh + ao) = hh;
    }
}
__device__ __forceinline__ void phase_scan2(const bf16_t* __restrict__ at, const bf16_t* __restrict__ bt, const float* __restrict__ agga, const float* __restrict__ aggh, const bf16_t* __restrict__ gate, bf16_t* __restrict__ acta) {
    const int tid = otid();
    for (int item = obid(); item < 256; item += gridDim.x) {
        const int b = item >> 7, chunk = (item >> 1) & 63, half = item & 1, c = half * 1024 + 2 * tid;
        f32x2 hh = {0.f, 0.f};
        for (int k = 0; k < chunk; ++k) { const size_t ao = (size_t)(b * 64 + k) * D + c; hh = *(const f32x2*)(agga + ao) * hh + *(const f32x2*)(aggh + ao); }
        const size_t r0 = (size_t)(b * S + chunk * 64) * D + c;
#pragma unroll 16
        for (int t = 0; t < 64; ++t) { const size_t o = r0 + (size_t)t * D; const unsigned au = __builtin_nontemporal_load((const unsigned*)(at + o)), bu = __builtin_nontemporal_load((const unsigned*)(bt + o)), gu = __builtin_nontemporal_load((const unsigned*)(gate + o));
            const f32x2 a2 = {__expf(__uint_as_float(au << 16)), __expf(__uint_as_float(au & 0xffff0000u))}, b2 = {__uint_as_float(bu << 16), __uint_as_float(bu & 0xffff0000u)};
            hh = a2 * hh + b2;
            *(unsigned*)(acta + o) = cvt_pk_bf16(hh.x * __uint_as_float(gu << 16), hh.y * __uint_as_float(gu & 0xffff0000u)); }
    }
}

__device__ __forceinline__ void phase_recur(const bf16_t* Rg, const bf16_t* Kg, const bf16_t* Vg, const float* DECg, const float* AAg,
                                            const float* k_k, const float* k_a, const float* r_k, float* BON, float* Yg, LAS unsigned char* lds) {
    constexpr int CH = 32, NCH = S / CH;
    constexpr int OFF_V_ = 5 * CH * 64, OFF_YP = OFF_V_ + CH * 16, BUF_F = OFF_YP + CH * 256;
    LAS float* L = (LAS float*)lds;
    const int tid = otid(), wave = tid >> 6, lane = tid & 63;
    for (int it0 = obid(); it0 < 256; it0 += gridDim.x) {
        const int item = (gridDim.x == 256) ? ((it0 & 7) * 32 + (it0 >> 3)) : it0;
        const int b = item >> 7, hh = (item >> 2) & 31, q = item & 3;
        const size_t rowbase = (size_t)b * S;
        const int colh = hh * 64;
        const int ltid = tid - 256, lt = (ltid >> 4) & 15, lj0 = (ltid & 15) * 4, vt = (ltid >> 2) & 31, vi = (ltid & 3) * 4;
        const bool vldr = ltid < 128;
        __syncthreads();
        if (wave >= 4) {
            const f32x4 kkc = *(const f32x4*)(k_k + colh + lj0), kac = *(const f32x4*)(k_a + colh + lj0), rkc = *(const f32x4*)(r_k + colh + lj0);
            f32x4 ga0A = {0, 0, 0, 0}, ga1A = {0, 0, 0, 0}, gd0A = {0, 0, 0, 0}, gd1A = {0, 0, 0, 0}; u32x2 gk0A = {0, 0}, gk1A = {0, 0}, gr0A = {0, 0}, gr1A = {0, 0}, gvrA = {0, 0};
            f32x4 ga0B = {0, 0, 0, 0}, ga1B = {0, 0, 0, 0}, gd0B = {0, 0, 0, 0}, gd1B = {0, 0, 0, 0}; u32x2 gk0B = {0, 0}, gk1B = {0, 0}, gr0B = {0, 0}, gr1B = {0, 0}, gvrB = {0, 0};
#define RC_GLOAD(X, ch) do { if ((ch) < NCH) { const size_t go = (rowbase + (size_t)(ch) * CH + lt) * D + colh + lj0, go1 = go + (size_t)16 * D; \
                gk0##X = *(const u32x2*)(Kg + go); gr0##X = *(const u32x2*)(Rg + go); ga0##X = *(const f32x4*)(AAg + go); gd0##X = *(const f32x4*)(DECg + go); \
                gk1##X = *(const u32x2*)(Kg + go1); gr1##X = *(const u32x2*)(Rg + go1); ga1##X = *(const f32x4*)(AAg + go1); gd1##X = *(const f32x4*)(DECg + go1); \
                if (vldr) gvr##X = *(const u32x2*)(Vg + (rowbase + (size_t)(ch) * CH + vt) * D + colh + q * 16 + vi); } } while (0)
#define RC_LW1(B, kraw, rraw, av, dv, tt, chk) do { const f32x4 kf = unpack4(kraw), rf = unpack4(rraw); f32x4 nn = kf * kkc; \
                const float ss = row16_allsum((nn.x * nn.x + nn.y * nn.y) + (nn.z * nn.z + nn.w * nn.w)); \
                const float inv = __builtin_amdgcn_rcpf(fmaxf(__builtin_amdgcn_sqrtf(ss), 1e-12f)); nn = nn * inv; \
                const f32x4 one = {1.f, 1.f, 1.f, 1.f}; const int lo = (tt) * 64 + lj0; const f32x4 km = kf * (one + (av - one) * kac), bt_ = rf * km * rkc; \
                const float bs = row16_allsum((bt_.x + bt_.y) + (bt_.z + bt_.w)); \
                if (q == 0 && (ltid & 15) == 0) BON[(rowbase + (size_t)(chk) * CH + (tt)) * 32 + hh] = bs;     \
                *(LAS f32x4*)(B + 0 * CH * 64 + lo) = dv; *(LAS f32x4*)(B + 1 * CH * 64 + lo) = nn; *(LAS f32x4*)(B + 2 * CH * 64 + lo) = nn * av; \
                *(LAS f32x4*)(B + 3 * CH * 64 + lo) = km; *(LAS f32x4*)(B + 4 * CH * 64 + lo) = rf; } while (0)
#define RC_LWRITE(X, buf, chk) do { LAS float* B = L + (buf) * BUF_F; RC_LW1(B, gk0##X, gr0##X, ga0##X, gd0##X, lt, chk); RC_LW1(B, gk1##X, gr1##X, ga1##X, gd1##X, lt + 16, chk); \
                if (vldr) *(LAS f32x4*)(B + OFF_V_ + vt * 16 + vi) = unpack4(gvr##X); } while (0)
#define RC_FLUSH(ch, buf) do { if (wave >= 6) { const LAS float* Bp = L + (buf) * BUF_F + OFF_YP + (wave - 6) * 16 * 256 + lane * 4; \
                float* yo = Yg + (rowbase + (size_t)(ch) * CH + (wave - 6) * 16) * D + colh + q * 16 + (lane >> 2); \
                _Pragma("unroll") for (int _i = 0; _i < 16; ++_i) { const f32x4 p4 = *(const LAS f32x4*)(Bp + _i * 256); float sq = (p4.x + p4.y) + (p4.z + p4.w); \
                    sq += dpp_f<0xB1>(sq); sq += dpp_f<0x4E>(sq); if ((lane & 3) == 0) yo[(size_t)_i * D] = sq; } } } while (0)
            RC_GLOAD(A, 0); RC_LWRITE(A, 0, 0); RC_GLOAD(A, 1); RC_GLOAD(B, 2);
            __syncthreads();
            for (int ch = 0; ch < NCH; ch += 2) {
                RC_LWRITE(A, 1, ch + 1); RC_GLOAD(A, ch + 3);
                if (ch >= 1) RC_FLUSH(ch - 1, 1);
                __syncthreads();
                if (ch + 2 < NCH) { RC_LWRITE(B, 0, ch + 2); RC_GLOAD(B, ch + 4); }
                RC_FLUSH(ch, 0);
                __syncthreads();
            }
            RC_FLUSH(NCH - 1, 1);
#undef RC_GLOAD
#undef RC_LW1
#undef RC_LWRITE
#undef RC_FLUSH
        } else {
            __syncthreads();
            const int rl = wave * 4 + (lane >> 4), js = lane & 15;
            f32x2 sa = {0.f, 0.f}, sb = {0.f, 0.f};
            for (int ch = 0; ch < NCH; ++ch) {
                LAS float* B = L + (ch & 1) * BUF_F;
                const LAS float* pj = B + js * 4; const LAS float* pv = B + OFF_V_ + rl; LAS float* py = B + OFF_YP + rl * 16 + js;
                f32x4 w4 = *(const LAS f32x4*)(pj + 0 * CH * 64), k4 = *(const LAS f32x4*)(pj + 1 * CH * 64), b4 = *(const LAS f32x4*)(pj + 2 * CH * 64);
                f32x4 m4 = *(const LAS f32x4*)(pj + 3 * CH * 64), r4 = *(const LAS f32x4*)(pj + 4 * CH * 64); float v = pv[0];
#pragma unroll
                for (int t = 0; t < CH; ++t) {
                    const int tn = (t + 1 < CH) ? t + 1 : t;
                    const f32x4 w4n = *(const LAS f32x4*)(pj + 0 * CH * 64 + tn * 64), k4n = *(const LAS f32x4*)(pj + 1 * CH * 64 + tn * 64), b4n = *(const LAS f32x4*)(pj + 2 * CH * 64 + tn * 64);
                    const f32x4 m4n = *(const LAS f32x4*)(pj + 3 * CH * 64 + tn * 64), r4n = *(const LAS f32x4*)(pj + 4 * CH * 64 + tn * 64); const float vn = pv[tn * 16];
                    const f32x2 pk = sa * k4.xy + sb * k4.zw;
                    const float p = row16_allsum(pk.x + pk.y);
                    const f32x2 pp = {p, p}, vv = {v, v};
                    sa = sa * w4.xy + (vv * m4.xy - pp * b4.xy);
                    sb = sb * w4.zw + (vv * m4.zw - pp * b4.zw);
                    const f32x2 yk = sa * r4.xy + sb * r4.zw;
                    py[t * 256] = yk.x + yk.y;
                    w4 = w4n; k4 = k4n; b4 = b4n; m4 = m4n; r4 = r4n; v = vn;
                }
                __syncthreads();
            }
        }
    }
}

__device__ __forceinline__ float oct_allsum(float x) {
    x += dpp_f<0x141>(x); x += dpp_f<0x4E>(x); x += dpp_f<0xB1>(x); return x;
}
__device__ __forceinline__ void phase_gn(const float* __restrict__ Yg, const bf16_t* __restrict__ Vg, const bf16_t* __restrict__ GGg, const float* __restrict__ BON,
                                         const float* __restrict__ ln_g, const float* __restrict__ ln_b, bf16_t* __restrict__ acta) {
    const int tid = otid(), lane = tid & 63, gw = obid() * 8 + (tid >> 6), NGW = gridDim.x * 8;
    for (int row = gw; row < T; row += NGW) {
        const size_t ro = (size_t)row * D;
#pragma unroll 2
        for (int j = 0; j < 4; ++j) { const int c = (64 * j + lane) * 8; const size_t o = ro + c;
            const f32x4 y0 = __builtin_nontemporal_load((const f32x4*)(Yg + o)), y1 = __builtin_nontemporal_load((const f32x4*)(Yg + o + 4));
            f32x4 v0, v1, g0, g1;
            unpack8(__builtin_nontemporal_load((const u32x4*)(Vg + o)), v0, v1); unpack8(__builtin_nontemporal_load((const u32x4*)(GGg + o)), g0, g1);
            const float sb = BON[(size_t)row * 32 + (c >> 6)];
            const f32x4 lg0 = *(const f32x4*)(ln_g + c), lg1 = *(const f32x4*)(ln_g + c + 4), lb0 = *(const f32x4*)(ln_b + c), lb1 = *(const f32x4*)(ln_b + c + 4);
            float sm = ((y0.x + y0.y) + (y0.z + y0.w)) + ((y1.x + y1.y) + (y1.z + y1.w));
            sm = oct_allsum(sm);
            const float mean = sm * (1.f / 64.f); const f32x4 d0 = y0 - mean, d1 = y1 - mean;
            float sv = ((d0.x * d0.x + d0.y * d0.y) + (d0.z * d0.z + d0.w * d0.w)) + ((d1.x * d1.x + d1.y * d1.y) + (d1.z * d1.z + d1.w * d1.w)); sv = oct_allsum(sv);
            const float rstd = 1.f / sqrtf(sv * (1.f / 64.f) + 64e-5f);
            *(u32x4*)(acta + o) = pack8((d0 * rstd * lg0 + lb0 + v0 * sb) * g0, (d1 * rstd * lg1 + lb1 + v1 * sb) * g1); }
    }
}

__device__ __forceinline__ void run_phase(const Params& P, int ph, LAS unsigned char* lds) {
    unsigned char* ws = P.ws;
    float* H0 = (float*)(ws + OFF_H); float* H1 = (float*)(ws + OFF_H2); bf16_t* ACTA = (bf16_t*)(ws + OFF_ACTA);
    const int G = gridDim.x, c = obid();
    if (ph == 0) { if constexpr (KEN(20)) { phase_convert(P, lds); phase_norm<false>(in_ptr(P, 0), in_ptr(P, 1), ACTA, nullptr); } return; }
    if (ph == 39) { if constexpr (KEN(21)) phase_norm<true>(H1, in_ptr(P, 5), nullptr, P.out); return; }
    const int p = ph - 1, pair = p / 19, r = p % 19;
    const bool is_rg = r < 10; const int layer = 2 * pair + (is_rg ? 0 : 1), sub = is_rg ? r : r - 10, j = pair;
    const float* hsrc = (layer == 0) ? in_ptr(P, 0) : H1;
    int kind;
    if (is_rg) kind = sub; else kind = (sub < 5) ? 10 + sub : sub + 1;
    switch (kind) {
    case 0: if constexpr (KEN(0)) phase_norm<false>(hsrc, in_ptr(P, 1) + (size_t)layer * D, ACTA, nullptr); break;
    case 7: if constexpr (KEN(0)) phase_norm<false>(H0, in_ptr(P, 2) + (size_t)layer * D, ACTA, nullptr); break;
    case 1: if constexpr (KEN(1)) { pg8::Gemm g{ACTA, w_rg(P, j, 0), T, 2 * D, D, D, D}; pg8::Order<0> So; So.init(T, 2 * D, G, c);
        EpiInProj E{(bf16_t*)(ws + OFF_GATE), (bf16_t*)(ws + OFF_REC)}; pg8::gemm_phase(lds, g, So, E); break; }
    case 2: if constexpr (KEN(2)) phase_conv((const bf16_t*)(ws + OFF_REC), in_ptr(P, 7) + (size_t)j * 4 * D, in_ptr(P, 8) + (size_t)j * D, (bf16_t*)(ws + OFF_CVB)); break;
    case 3: if constexpr (KEN(3)) { pg8::Gemm g{(const bf16_t*)(ws + OFF_CVB), w_rg(P, j, 1), T, 2 * D, 256, D, 256}; pg8::Order<1> So; So.init(T, 2 * D, G, c);
        EpiGates E{in_ptr(P, 10) + (size_t)j * D, in_ptr(P, 12) + (size_t)j * D, in_ptr(P, 13) + (size_t)j * D, (const bf16_t*)(ws + OFF_CVB), (bf16_t*)(ws + OFF_AT), (bf16_t*)(ws + OFF_BT)};
        pg8::gemm_phase(lds, g, So, E); break; }
    case 4: if constexpr (KEN(4)) phase_scan1((const bf16_t*)(ws + OFF_AT), (const bf16_t*)(ws + OFF_BT), (float*)(ws + OFF_AGGA), (float*)(ws + OFF_AGGH)); break;
    case 5: if constexpr (KEN(5)) phase_scan2((const bf16_t*)(ws + OFF_AT), (const bf16_t*)(ws + OFF_BT), (const float*)(ws + OFF_AGGA), (const float*)(ws + OFF_AGGH), (const bf16_t*)(ws + OFF_GATE), ACTA); break;
    case 6: case 9: if constexpr (KEN(6)) { const bool down = (kind == 9);
        const bf16_t* A = down ? (const bf16_t*)(ws + OFF_U) : ACTA; const bf16_t* Bt = down ? w_mlp(P, layer, 1) : (is_rg ? w_rg(P, j, 2) : w_rw(P, j, 2));
        const int K = down ? FF : D; pg8::Gemm g{A, Bt, T, D, K, K, K}; pg8::Order<0> So; So.init(T, D, G, c);
        EpiResidual E{down ? (const float*)H0 : hsrc, down ? H1 : H0}; pg8::gemm_phase(lds, g, So, E); break; }
    case 8: if constexpr (KEN(8)) { pg8::Gemm g{ACTA, w_mlp(P, layer, 0), T, FF, D, D, D}; pg8::Order<0> So; So.init(T, FF, G, c);
        EpiUp E{(bf16_t*)(ws + OFF_U)}; pg8::gemm_phase(lds, g, So, E); break; }
    case 10: if constexpr (KEN(10)) phase_mix(hsrc, in_ptr(P, 1) + (size_t)layer * D, in_ptr(P, 15) + (size_t)j * 6 * D, (bf16_t*)(ws + OFF_XM)); break;
    case 11: if constexpr (KEN(11)) { pg8::Gemm g{(const bf16_t*)(ws + OFF_XM), w_rw(P, j, 0), T, 6912, D, D, D}; pg8::Order<2> So; So.init(T, 6912, G, c);
        EpiRKV E{ws + OFF_R, (bf16_t*)(ws + OFF_LORA)}; pg8::gemm_phase(lds, g, So, E);
        { const int nfull = 864 % G; if (nfull != 0 && c >= nfull) { const int wv = __builtin_amdgcn_readfirstlane(otid() >> 6); convert_jobs(P, lds, 4 + 2 * j, 6 + 2 * j, (c - nfull) * 8 + wv, (G - nfull) * 8); }
          else if (nfull == 0) { const int wv = __builtin_amdgcn_readfirstlane(otid() >> 6); convert_jobs(P, lds, 4 + 2 * j, 6 + 2 * j, c * 8 + wv, G * 8); } }
        break; }
    case 12: if constexpr (KEN(12)) { pg8::Gemm g{(const bf16_t*)(ws + OFF_LORA), w_rw(P, j, 1), T, 6144, 256, 256, 256}; pg8::Order<3> So; So.init(T, 6144, G, c);
        EpiLoraUp E{in_ptr(P, 17) + (size_t)j * D, in_ptr(P, 20) + (size_t)j * D, (float*)(ws + OFF_DEC)}; pg8::gemm_phase(lds, g, So, E); break; }
    case 13: if constexpr (KEN(13)) phase_recur((const bf16_t*)(ws + OFF_R), (const bf16_t*)(ws + OFF_K), (const bf16_t*)(ws + OFF_V), (const float*)(ws + OFF_DEC), (const float*)(ws + OFF_AA),
                         in_ptr(P, 25) + (size_t)j * D, in_ptr(P, 26) + (size_t)j * D, in_ptr(P, 27) + (size_t)j * D, (float*)(ws + OFF_BON), (float*)(ws + OFF_YREC), lds); break;
    case 14: if constexpr (KEN(14)) phase_gn((const float*)(ws + OFF_YREC), (const bf16_t*)(ws + OFF_V), (const bf16_t*)(ws + OFF_GG), (const float*)(ws + OFF_BON),
                      in_ptr(P, 28) + (size_t)j * D, in_ptr(P, 29) + (size_t)j * D, ACTA); break;
    default: break;
    }
}

#define XB_TMO      128
#define XB_XCNT(j)  (256  + 64 * (j))
#define XB_XSUB(j)  (1280 + 64 * (j))
#define XB_XGEN(j)  (2304 + 64 * (j))
#define XB_TOP      3328
#define XB_TOPGEN   3392
#define XCD_BAR_WORDS 3456
#define XB_SPIN_CAP (1u << 20)
__device__ __forceinline__ unsigned xb_ld(unsigned* p)              { return __hip_atomic_load(p, __ATOMIC_RELAXED, __HIP_MEMORY_SCOPE_AGENT); }
__device__ __forceinline__ unsigned xb_add(unsigned* p, unsigned v) { return __hip_atomic_fetch_add(p, v, __ATOMIC_RELAXED, __HIP_MEMORY_SCOPE_AGENT); }
__device__ __forceinline__ unsigned xb_xcc_id() { return (unsigned)__builtin_amdgcn_s_getreg((3 << 11) | 20) & 0xFu; }
#define XB_SPIN(cond, bar) do { unsigned _sp = 0; while (cond) { __builtin_amdgcn_s_sleep(1); \
    if ((++_sp & 255u) == 0u) { if (xb_ld(&(bar)[XB_TMO])) break; if (_sp > XB_SPIN_CAP) { atomicAdd(&(bar)[XB_TMO], 1u); break; } } } } while (0)
struct XcdBarrier { unsigned* bar; unsigned x; volatile LAS unsigned* st; };
__device__ __forceinline__ XcdBarrier xcd_barrier_post(unsigned* bar, volatile LAS unsigned* st) {
    XcdBarrier b; b.bar = bar; b.x = xb_xcc_id(); b.st = st;
    if (threadIdx.x == 0) (void)xb_add(&bar[XB_XCNT(b.x)], 1u);
    return b;
}
__device__ __forceinline__ void xcd_barrier_complete(unsigned* bar, unsigned x, unsigned& nloc, unsigned& nx) {
    const unsigned G = gridDim.x * gridDim.y * gridDim.z;
    unsigned sum, cnt, mine, sp = 0u;
    for (;;) {
        sum = 0u; cnt = 0u; mine = 0u;
#pragma unroll
        for (unsigned j = 0; j < 16; ++j) { const unsigned c = xb_ld(&bar[XB_XCNT(j)]); sum += c; cnt += (c > 0u) ? 1u : 0u; mine = (j == x) ? c : mine; }
        if (sum == G) break;
        __builtin_amdgcn_s_sleep(1);
        if ((++sp & 255u) == 0u) { if (xb_ld(&bar[XB_TMO])) break; if (sp > XB_SPIN_CAP) { atomicAdd(&bar[XB_TMO], 1u); break; } }
    }
    nloc = mine > 0u ? mine : 1u; nx = cnt > 0u ? cnt : 1u;
}
__device__ __forceinline__ void xcd_barrier(const XcdBarrier& b) {
    asm volatile("s_waitcnt vmcnt(0)" ::: "memory");
    __syncthreads();
    if (threadIdx.x == 0) {
        unsigned* bar = b.bar;
        __builtin_amdgcn_s_waitcnt(0);
        unsigned nloc = b.st[0], nx = b.st[1];
        if (nloc == 0u) { xcd_barrier_complete(bar, b.x, nloc, nx); b.st[0] = nloc; b.st[1] = nx; }
        const unsigned old = xb_add(&bar[XB_XSUB(b.x)], 1u);
        const unsigned gen = old / nloc;
        if (old + 1u == (gen + 1u) * nloc) {
            __builtin_amdgcn_fence(__ATOMIC_RELEASE, "agent");
            asm volatile("s_waitcnt vmcnt(0)" ::: "memory");
            const unsigned og = xb_add(&bar[XB_TOP], 1u);
            const unsigned tg = og / nx;
            if (og + 1u == (tg + 1u) * nx) xb_add(&bar[XB_TOPGEN], 1u);
            else XB_SPIN(xb_ld(&bar[XB_TOPGEN]) == tg, bar);
            __builtin_amdgcn_fence(__ATOMIC_ACQUIRE, "agent");
            xb_add(&bar[XB_XGEN(b.x)], 1u);
            asm volatile("s_waitcnt vmcnt(0)" ::: "memory");
        } else {
            XB_SPIN(xb_ld(&bar[XB_XGEN(b.x)]) == gen, bar);
            __builtin_amdgcn_fence(__ATOMIC_ACQUIRE, "agent");
            asm volatile("s_waitcnt vmcnt(0)" ::: "memory");
        }
    }
    __syncthreads();
}

constexpr int N_PHASES = 40;

__global__ void __launch_bounds__(512, 2) mega(Params P) {
    extern __shared__ __attribute__((aligned(16))) unsigned char shm[];
    LAS unsigned char* lds = (LAS unsigned char*)shm;
    cg::grid_group grid = cg::this_grid();
    volatile LAS unsigned* st = (volatile LAS unsigned*)(lds + LDS_ST_OFF);
    if (threadIdx.x == 0) { st[0] = 0u; st[1] = 0u; }
    __syncthreads();
    const XcdBarrier xb = xcd_barrier_post((unsigned*)(P.ws + OFF_BAR), st);
    bool first_seam = true;
    for (int ph = P.ph_lo; ph < P.ph_hi; ++ph) {
        if (ph == 1) continue;
        int nrep = 1;
        if (REPMASK != 0u) {
            int kind; if (ph == 0) kind = 20; else if (ph == 39) kind = 21; else { const int r = (ph - 1) % 19; kind = r < 10 ? r : (r - 10 < 5 ? r : r - 9); }
            if ((REPMASK >> kind) & 1u) nrep = 2;
        }
        for (int rep = 0; rep < nrep; ++rep) {
            if (ph > P.ph_lo || rep > 0) {
                if (first_seam) { grid.sync(); first_seam = false; }
                else xcd_barrier(xb);
            }
            run_phase(P, ph, lds);
        }
    }
}

extern "C" void kernel_launch(void* const* d_in, const int* in_sizes, int n_in, void* d_out, int out_size, void* d_ws, size_t ws_size, hipStream_t stream) {
    static int grid = 0;
    if (grid == 0) {
        if (n_in != 31 || in_sizes[0] != T * D || out_size != T * D || ws_size < WS_END) {
            fprintf(stderr, "kernel_launch: unexpected shapes: n_in %d in0 %d out %d ws %zu (need %zu)\n", n_in, n_in > 0 ? in_sizes[0] : -1, out_size, ws_size, (size_t)WS_END); grid = -1; return; }
        int dev = 0, cus = 0, per_cu = 0;
        hipGetDevice(&dev); hipDeviceGetAttribute(&cus, hipDeviceAttributeMultiprocessorCount, dev);
        if (hipFuncSetAttribute((const void*)mega, hipFuncAttributeMaxDynamicSharedMemorySize, LDS_BYTES) != hipSuccess) { fprintf(stderr, "kernel_launch: hipFuncSetAttribute failed\n"); grid = -1; return; }
        if (hipOccupancyMaxActiveBlocksPerMultiprocessor(&per_cu, (const void*)mega, 512, LDS_BYTES) != hipSuccess || per_cu < 1) { fprintf(stderr, "kernel_launch: occupancy query says %d\n", per_cu); per_cu = 1; }
        (void)hipGetLastError();
        grid = cus * per_cu;
    }
    if (grid < 0) return;
    Params p{};
    for (int i = 0; i < 31; ++i) p.in[i] = (const float*)d_in[i];
    p.out = (float*)d_out; p.ws = (unsigned char*)d_ws;
    if (hipMemsetAsync((char*)d_ws + OFF_BAR, 0, XCD_BAR_WORDS * 4, stream) != hipSuccess) { fprintf(stderr, "kernel_launch: memset of the barrier words failed\n"); return; }
#if N_LAUNCH_PER_PHASE
    for (int ph = 0; ph < N_PHASES; ++ph) { p.ph_lo = ph; p.ph_hi = ph + 1; hipLaunchKernelGGL(mega, dim3(grid), dim3(512), LDS_BYTES, stream, p); }
#else
    p.ph_lo = 0; p.ph_hi = N_PHASES;
    void* args[] = {&p};
    hipError_t e = hipLaunchCooperativeKernel((const void*)mega, dim3(grid), dim3(512), args, LDS_BYTES, stream);
    if (e != hipSuccess) fprintf(stderr, "cooperative launch failed: %s (grid %d)\n", hipGetErrorString(e), grid);
#endif
}
```

```cpp
#include <hip/hip_runtime.h>
#include <hip/hip_cooperative_groups.h>
#include <cstdio>
#include <cstdint>
namespace cg = cooperative_groups;

#ifndef N_LAUNCH_PER_PHASE
#define N_LAUNCH_PER_PHASE 0
#endif

#ifndef KMASK
#define KMASK 0xffffffu
#endif
#define KEN(n) (((KMASK) >> (n)) & 1u)
#ifndef REPMASK
#define REPMASK 0u
#endif
#define LAS __attribute__((address_space(3)))
typedef unsigned short bf16_t;
typedef short bf16x8 __attribute__((ext_vector_type(8)));
typedef float f32x4 __attribute__((ext_vector_type(4)));
typedef float f32x2 __attribute__((ext_vector_type(2)));
typedef unsigned u32x2 __attribute__((ext_vector_type(2)));
typedef unsigned u32x4 __attribute__((ext_vector_type(4)));

constexpr int T = 8192, D = 2048, S = 4096, FF = 8192;
constexpr size_t MiB = 1ull << 20;
constexpr size_t TD = (size_t)T * D;
constexpr size_t SZ_W_RG = 26 * MiB;
constexpr size_t SZ_W_RW = 38 * MiB;
constexpr size_t SZ_W_MLP = 64 * MiB;
constexpr size_t OFF_W_RG = 0;
constexpr size_t OFF_W_RW = OFF_W_RG + 2 * SZ_W_RG;
constexpr size_t OFF_W_MLP = OFF_W_RW + 2 * SZ_W_RW;
constexpr size_t OFF_H = OFF_W_MLP + 4 * SZ_W_MLP;
constexpr size_t OFF_ACTA = OFF_H + 64 * MiB;
constexpr size_t OFF_X = OFF_ACTA + 32 * MiB;
constexpr size_t OFF_XM = OFF_X;
constexpr size_t OFF_DEC = OFF_X, OFF_AA = OFF_X + 64 * MiB, OFF_GG = OFF_X + 128 * MiB;
constexpr size_t OFF_R = OFF_X + 192 * MiB, OFF_K = OFF_R + 64 * MiB, OFF_V = OFF_K + 64 * MiB;
constexpr size_t OFF_LORA = OFF_X + 384 * MiB;
constexpr size_t OFF_YREC = OFF_X + 396 * MiB;
constexpr size_t OFF_GATE = OFF_X, OFF_REC = OFF_X + 64 * MiB, OFF_CV = OFF_X + 128 * MiB, OFF_CVB = OFF_X + 192 * MiB;
constexpr size_t OFF_AT = OFF_X + 224 * MiB, OFF_BT = OFF_X + 288 * MiB, OFF_AGGA = OFF_X + 352 * MiB, OFF_AGGH = OFF_X + 353 * MiB;
constexpr size_t OFF_U = OFF_X;
constexpr size_t OFF_H2 = OFF_X + 460 * MiB;
constexpr size_t OFF_BAR = OFF_H2 + 64 * MiB;
constexpr size_t OFF_BON = OFF_BAR + 1 * MiB;
constexpr size_t WS_END = OFF_BON + 1 * MiB;

constexpr int LDS_ST_OFF = 151552;
constexpr int LDS_BYTES = LDS_ST_OFF + 64;

struct Params {
    const float* in[31];
    float* out;
    unsigned char* ws;
    int ph_lo, ph_hi;
};

__device__ __forceinline__ const float* in_ptr(const Params& P, int i) { asm volatile("" : "+s"(i)); return P.in[i]; }
__device__ __forceinline__ unsigned cvt_pk_bf16(float lo, float hi) { unsigned r; asm volatile("v_cvt_pk_bf16_f32 %0, %1, %2" : "=v"(r) : "v"(lo), "v"(hi)); return r; }
__device__ __forceinline__ u32x2 pack4(f32x4 v) { u32x2 o; o.x = cvt_pk_bf16(v.x, v.y); o.y = cvt_pk_bf16(v.z, v.w); return o; }
__device__ __forceinline__ f32x4 unpack4(u32x2 u) { f32x4 o; o.x = __uint_as_float(u.x << 16); o.y = __uint_as_float(u.x & 0xffff0000u); o.z = __uint_as_float(u.y << 16); o.w = __uint_as_float(u.y & 0xffff0000u); return o; }
__device__ __forceinline__ void unpack8(u32x4 u, f32x4& a, f32x4& b) { a = unpack4((u32x2){u.x, u.y}); b = unpack4((u32x2){u.z, u.w}); }
__device__ __forceinline__ float wave_sum(float v) {
#pragma unroll
    for (int o = 1; o < 64; o <<= 1) v += __shfl_xor(v, o);
    return v;
}
__device__ __forceinline__ float sigmoidf_(float x) { return __builtin_amdgcn_rcpf(1.f + __expf(-x)); }
__device__ __forceinline__ float tanhf_(float x) { const float xc = fminf(fmaxf(x, -15.f), 15.f); return 1.f - 2.f * __builtin_amdgcn_rcpf(1.f + __expf(2.f * xc)); }
__device__ __forceinline__ float gelu_tanh(float x) { const float u = 0.7978845608028654f * (x + 0.044715f * x * x * x); return 0.5f * x * (1.f + tanhf_(u)); }
__device__ __forceinline__ float neg_expm1(float x) { return (fabsf(x) < 0.02f) ? -x * (1.f + x * (0.5f + x * (0.16666667f + x * 0.041666668f))) : 1.f - __expf(x); }
__device__ __forceinline__ int otid() { int t; asm volatile("v_mov_b32 %0, %1" : "=v"(t) : "v"((int)threadIdx.x)); return t; }
__device__ __forceinline__ int obid() { int t; asm volatile("s_mov_b32 %0, %1" : "=s"(t) : "s"((int)blockIdx.x)); return t; }
template <int CTRL> __device__ __forceinline__ float dpp_f(float v) { return __builtin_bit_cast(float, __builtin_amdgcn_update_dpp(0, __builtin_bit_cast(int, v), CTRL, 0xf, 0xf, false)); }
__device__ __forceinline__ float row16_allsum(float p) {
    p += dpp_f<0x128>(p); p += dpp_f<0x124>(p); p += dpp_f<0x122>(p); p += dpp_f<0x121>(p); return p;
}

namespace pg8 {
constexpr int BM = 256, BK = 64, HALF = 128, HTB = HALF * BK * 2, STAGE_BYTES = 8 * HTB, NXCD = 8, WGM = 8;
__host__ __device__ __forceinline__ int lds_byte(int r, int c) { const int st = (r >> 4) * 2 + (c >> 5), rr = r & 15, cc = c & 31, ob = rr * 64 + cc * 2; return st * 1024 + (ob ^ (((ob >> 9) & 1) << 5)); }
__host__ __device__ __forceinline__ void stage_rc(int b, int& R, int& C) { const int st = b / 1024, sb = b % 1024, swz = sb ^ (((sb >> 9) & 1) << 5); R = (st >> 1) * 16 + swz / 64; C = (st & 1) * 32 + (swz % 64) / 2; }
__host__ __device__ __forceinline__ int perm32(int rho) { const int n = rho >> 4, i = rho & 15; return 8 * (i >> 2) + 4 * n + (i & 3); }
struct Unit { int pm, pn; };
struct Gemm { const bf16_t* A; const bf16_t* Bt; int M, N, K, lda, ldb; };
template <int AMODE> struct Order {
    int nM, nN, nwg, G, c;
    __device__ void init(int M, int N, int G_, int c_) { nM = M / BM; nN = N / BM; nwg = nM * nN; G = G_; c = c_; }
    __device__ bool next(int i, Unit& u) const {
        const long L = (long)i * G + c; if (L >= nwg) return false;
        int wgid = (int)L; { const int q = nwg / NXCD, r = nwg % NXCD, xcd = wgid % NXCD, off = wgid / NXCD; wgid = (xcd < r ? xcd * (q + 1) : r * (q + 1) + (xcd - r) * q) + off; }
        const int nig = WGM * nN, gid = wgid / nig, fm = gid * WGM, gsz = (nM - fm) < WGM ? (nM - fm) : WGM;
        u.pm = fm + ((wgid % nig) % gsz); u.pn = (wgid % nig) / gsz; return true;
    }
    __device__ __forceinline__ size_t a_off(const Unit& u) const {
        if (AMODE == 1) return (size_t)(u.pn >> 1) * 512;
        if (AMODE == 2) { const int w = u.pn < 24 ? (u.pn >> 3) : (u.pn - 21); return (size_t)w * TD * 2; }
        if (AMODE == 3) return (size_t)(u.pn >> 3) * ((size_t)T * 256 * 2);
        return 0;
    }
};

#ifndef PG8_SP2
#define PG8_SP2 true
#endif
#ifndef PG8_ALIGN
#define PG8_ALIGN true
#endif
template <class Epi, class Sched, bool ALIGN_EPI = PG8_ALIGN, bool SP2 = PG8_SP2>
__device__ __forceinline__ void gemm_phase(LAS unsigned char* lds, const Gemm g, const Sched& S, const Epi& E) {
    int tid; asm volatile("v_mov_b32 %0, %1" : "=v"(tid) : "v"((int)threadIdx.x));
    const int wid = __builtin_amdgcn_readfirstlane(tid >> 6), lane = tid & 63, wr = wid >> 2, wc = wid & 3, fr = lane & 15, fq = lane >> 4;
    const int K = g.K, nt = K / BK;
    unsigned voffA[2], voffB[2];
#pragma unroll
    for (int i = 0; i < 2; ++i) { int R, C; stage_rc(tid * 16 + i * 8192, R, C);
        const int Rb = Epi::PERM ? ((R & ~31) + perm32(R & 31)) : R;
        voffA[i] = (unsigned)(R * g.lda + C) * 2u; voffB[i] = (unsigned)(Rb * g.ldb + C) * 2u; }
    const size_t kstep = (size_t)(BK * 2);
    const size_t hstepA = (size_t)HALF * g.lda * 2, hstepB = (size_t)HALF * g.ldb * 2;
    const size_t tstepA = 2 * hstepA, tstepB = 2 * hstepB;
    const unsigned ldsw = (unsigned)wid * 1024u;
    const int aoff = lds_byte(wr * 64 + fr, fq * 8), boff = lds_byte(wc * 32 + fr, fq * 8);
#define PG8_SA(b, h) (((b) * 2 + (h)) * HTB)
#define PG8_SB(b, h) ((4 + (b) * 2 + (h)) * HTB)
#define PG8_STAGE(bufoff, gbase, voff) do { _Pragma("unroll") for (int _i = 0; _i < 2; ++_i) \
        __builtin_amdgcn_global_load_lds((const unsigned*)((const char*)(gbase) + (voff)[_i]), (LAS unsigned*)(lds + (bufoff) + ldsw + _i * 8192), 16, 0, 0); } while (0)
#define PG8_LDA(dst, b, h) do { _Pragma("unroll") for (int m = 0; m < 4; ++m) _Pragma("unroll") for (int k = 0; k < 2; ++k) dst[m][k] = *(const LAS bf16x8*)(lds + PG8_SA(b, h) + aoff + m * 2048 + k * 1024); } while (0)
#define PG8_LDB(dst, b, h) do { _Pragma("unroll") for (int n = 0; n < 2; ++n) _Pragma("unroll") for (int k = 0; k < 2; ++k) dst[n][k] = *(const LAS bf16x8*)(lds + PG8_SB(b, h) + boff + n * 2048 + k * 1024); } while (0)
#define PG8_MMA(ai, bj, At, Bt) do { __builtin_amdgcn_s_setprio(1); _Pragma("unroll") for (int m = 0; m < 4; ++m) _Pragma("unroll") for (int n = 0; n < 2; ++n) _Pragma("unroll") for (int k = 0; k < 2; ++k) \
        acc[ai][bj][m][n] = __builtin_amdgcn_mfma_f32_16x16x32_bf16(Bt[n][k], At[m][k], acc[ai][bj][m][n], 0, 0, 0); __builtin_amdgcn_s_setprio(0); } while (0)
#define PG8_WAIT_V(n) asm volatile("s_waitcnt vmcnt(" #n ")" ::: "memory")
#define PG8_WAIT_L(n) asm volatile("s_waitcnt lgkmcnt(" #n ")" ::: "memory")
#define PG8_BAR __builtin_amdgcn_s_barrier()
#define PG8_SCHED __builtin_amdgcn_sched_barrier(0)
    Unit cur, nxt; int ui = 0;
    if (!S.next(0, cur)) return;
    f32x4 acc[2][2][4][2];
#pragma unroll
    for (int a = 0; a < 2; ++a)
#pragma unroll
        for (int b = 0; b < 2; ++b)
#pragma unroll
            for (int m = 0; m < 4; ++m)
#pragma unroll
                for (int n = 0; n < 2; ++n) acc[a][b][m][n] = (f32x4){0.f, 0.f, 0.f, 0.f};
    bf16x8 At[4][2], B0[2][2], B1[2][2];
    const char* cA = (const char*)g.A + (size_t)cur.pm * tstepA + S.a_off(cur); const char* cB = (const char*)g.Bt + (size_t)cur.pn * tstepB;
    if constexpr (SP2) {
        PG8_STAGE(PG8_SB(0, 0), cB, voffB); PG8_STAGE(PG8_SB(0, 1), cB + hstepB, voffB); PG8_STAGE(PG8_SA(0, 0), cA, voffA); PG8_STAGE(PG8_SA(0, 1), cA + hstepA, voffA);
        if (wr == 1) PG8_BAR;
        PG8_WAIT_V(2); PG8_BAR;
        PG8_STAGE(PG8_SB(1, 0), cB + kstep, voffB); PG8_STAGE(PG8_SA(1, 0), cA + kstep, voffA); PG8_STAGE(PG8_SB(1, 1), cB + hstepB + kstep, voffB);
        PG8_WAIT_V(6); PG8_BAR;
    } else {
        PG8_STAGE(PG8_SB(0, 0), cB, voffB); PG8_STAGE(PG8_SA(0, 0), cA, voffA); PG8_STAGE(PG8_SB(0, 1), cB + hstepB, voffB); PG8_STAGE(PG8_SA(0, 1), cA + hstepA, voffA);
        if (wr == 1) PG8_BAR;
        PG8_WAIT_V(4); PG8_BAR;
        PG8_STAGE(PG8_SB(1, 0), cB + kstep, voffB); PG8_STAGE(PG8_SA(1, 0), cA + kstep, voffA); PG8_STAGE(PG8_SB(1, 1), cB + hstepB + kstep, voffB);
        PG8_WAIT_V(6); PG8_BAR;
    }
    for (;;) {
        const bool has_next = S.next(ui + 1, nxt);
        const char* nA = has_next ? (const char*)g.A + (size_t)nxt.pm * tstepA + S.a_off(nxt) : cA; const char* nB = has_next ? (const char*)g.Bt + (size_t)nxt.pn * tstepB : cB;
#pragma unroll 1
        for (int t = 0; t < nt; t += 2) {
            const bool last = (t == nt - 2);
            const char* a1 = cA + (size_t)(t + 1) * kstep;
            const char* a2 = last ? nA : cA + (size_t)(t + 2) * kstep; const char* b2 = last ? nB : cB + (size_t)(t + 2) * kstep;
            const char* a3 = a2 + kstep; const char* b3 = b2 + kstep;
            if constexpr (SP2) {
            PG8_LDB(B0, 0, 0); PG8_LDB(B1, 0, 1); PG8_SCHED; PG8_LDA(At, 0, 0); PG8_STAGE(PG8_SA(1, 1), a1 + hstepA, voffA);
            PG8_WAIT_V(8); PG8_WAIT_L(0); PG8_BAR; PG8_MMA(0, 0, At, B0); PG8_MMA(0, 1, At, B1); PG8_BAR; PG8_SCHED;
            PG8_LDA(At, 0, 1); PG8_STAGE(PG8_SB(0, 0), b2, voffB); PG8_STAGE(PG8_SB(0, 1), b2 + hstepB, voffB); PG8_STAGE(PG8_SA(0, 0), a2, voffA);
            PG8_WAIT_V(8); PG8_WAIT_L(0); PG8_BAR; PG8_MMA(1, 0, At, B0); PG8_MMA(1, 1, At, B1); PG8_BAR; PG8_SCHED;
            PG8_LDB(B0, 1, 0); PG8_LDB(B1, 1, 1); PG8_SCHED; PG8_LDA(At, 1, 0); PG8_STAGE(PG8_SA(0, 1), a2 + hstepA, voffA);
            PG8_WAIT_V(8); PG8_WAIT_L(0); PG8_BAR; PG8_MMA(0, 0, At, B0); PG8_MMA(0, 1, At, B1); PG8_BAR; PG8_SCHED;
            PG8_LDA(At, 1, 1); PG8_STAGE(PG8_SB(1, 0), b3, voffB); PG8_STAGE(PG8_SB(1, 1), b3 + hstepB, voffB); PG8_STAGE(PG8_SA(1, 0), a3, voffA);
            PG8_WAIT_V(8); PG8_WAIT_L(0); PG8_BAR; PG8_MMA(1, 0, At, B0); PG8_MMA(1, 1, At, B1); PG8_BAR; PG8_SCHED;
            } else {
            PG8_LDB(B0, 0, 0); PG8_SCHED; PG8_LDA(At, 0, 0); PG8_STAGE(PG8_SA(1, 1), a1 + hstepA, voffA);
            PG8_WAIT_L(8); PG8_BAR; PG8_WAIT_L(0); PG8_MMA(0, 0, At, B0); PG8_BAR; PG8_SCHED;
            PG8_LDB(B1, 0, 1); PG8_STAGE(PG8_SB(0, 0), b2, voffB);
            PG8_BAR; PG8_WAIT_L(0); PG8_MMA(0, 1, At, B1); PG8_BAR;
            PG8_LDA(At, 0, 1); PG8_STAGE(PG8_SA(0, 0), a2, voffA);
            PG8_BAR; PG8_WAIT_L(0); PG8_MMA(1, 0, At, B0); PG8_BAR; PG8_SCHED;
            PG8_STAGE(PG8_SB(0, 1), b2 + hstepB, voffB);
            PG8_WAIT_V(6); PG8_BAR; PG8_MMA(1, 1, At, B1); PG8_BAR;
            PG8_LDB(B0, 1, 0); PG8_SCHED; PG8_LDA(At, 1, 0); PG8_STAGE(PG8_SA(0, 1), a2 + hstepA, voffA);
            PG8_WAIT_L(8); PG8_BAR; PG8_WAIT_L(0); PG8_MMA(0, 0, At, B0); PG8_BAR; PG8_SCHED;
            PG8_LDB(B1, 1, 1); PG8_STAGE(PG8_SB(1, 0), b3, voffB);
            PG8_BAR; PG8_WAIT_L(0); PG8_MMA(0, 1, At, B1); PG8_BAR;
            PG8_LDA(At, 1, 1); PG8_STAGE(PG8_SA(1, 0), a3, voffA);
            PG8_BAR; PG8_WAIT_L(0); PG8_MMA(1, 0, At, B0); PG8_BAR; PG8_SCHED;
            PG8_STAGE(PG8_SB(1, 1), b3 + hstepB, voffB);
            PG8_WAIT_V(6); PG8_BAR; PG8_MMA(1, 1, At, B1); PG8_BAR;
                    }
        }
        if constexpr (ALIGN_EPI) { if (wr == 0) PG8_BAR; }
        E(acc, cur, wr, wc, fr, fq);
        if (!has_next) break;
#pragma unroll
        for (int a = 0; a < 2; ++a)
#pragma unroll
            for (int b = 0; b < 2; ++b)
#pragma unroll
                for (int m = 0; m < 4; ++m)
#pragma unroll
                    for (int n = 0; n < 2; ++n) acc[a][b][m][n] = (f32x4){0.f, 0.f, 0.f, 0.f};
        cur = nxt; cA = nA; cB = nB; ++ui;
        if constexpr (ALIGN_EPI) { if (wr == 1) PG8_BAR; }
    }
    PG8_WAIT_V(0);
    if constexpr (!ALIGN_EPI) { if (wr == 0) PG8_BAR; }
    PG8_BAR;
#undef PG8_SA
#undef PG8_SB
#undef PG8_STAGE
#undef PG8_LDA
#undef PG8_LDB
#undef PG8_MMA
#undef PG8_WAIT_V
#undef PG8_WAIT_L
#undef PG8_BAR
#undef PG8_SCHED
}
}
using pg8::Unit;
typedef f32x4 Acc[2][2][4][2];
__device__ __forceinline__ u32x4 pack8(f32x4 a, f32x4 b) { u32x4 o; o.x = cvt_pk_bf16(a.x, a.y); o.y = cvt_pk_bf16(a.z, a.w); o.z = cvt_pk_bf16(b.x, b.y); o.w = cvt_pk_bf16(b.z, b.w); return o; }

struct EpiResidual {
    static constexpr bool PERM = true;
    const float* src; float* out;
    __device__ __forceinline__ void operator()(const Acc& acc, const Unit& u, int wr, int wc, int fr, int fq) const {
        const int row0 = u.pm * 256 + wr * 64 + fr, col0 = u.pn * 256 + wc * 32 + 8 * fq;
#pragma unroll
        for (int ai = 0; ai < 2; ++ai)
#pragma unroll
            for (int m = 0; m < 4; ++m) { const size_t ro = (size_t)(row0 + ai * 128 + m * 16) * D + col0;
#pragma unroll
                for (int bj = 0; bj < 2; ++bj) { const size_t o = ro + bj * 128;
                    const f32x4 h0 = *(const f32x4*)(src + o) + acc[ai][bj][m][0], h1 = *(const f32x4*)(src + o + 4) + acc[ai][bj][m][1];
                    *(f32x4*)(out + o) = h0; *(f32x4*)(out + o + 4) = h1; } }
    }
};
struct EpiInProj {
    static constexpr bool PERM = true;
    bf16_t* gate; bf16_t* rec;
    __device__ __forceinline__ void operator()(const Acc& acc, const Unit& u, int wr, int wc, int fr, int fq) const {
        const bool isg = u.pn < 8; bf16_t* dst = isg ? gate : rec;
        const int row0 = u.pm * 256 + wr * 64 + fr, col0 = (u.pn & 7) * 256 + wc * 32 + 8 * fq;
#pragma unroll
        for (int ai = 0; ai < 2; ++ai)
#pragma unroll
            for (int m = 0; m < 4; ++m) { const size_t ro = (size_t)(row0 + ai * 128 + m * 16) * D + col0;
#pragma unroll
                for (int bj = 0; bj < 2; ++bj) { f32x4 v0 = acc[ai][bj][m][0], v1 = acc[ai][bj][m][1];
                    if (isg) {
#pragma unroll
                        for (int j = 0; j < 4; ++j) { v0[j] = gelu_tanh(v0[j]); v1[j] = gelu_tanh(v1[j]); } }
                    *(u32x4*)(dst + ro + bj * 128) = pack8(v0, v1); } }
    }
};
struct EpiGates {
    static constexpr bool PERM = true;
    const float* gxb; const float* gab; const float* lam; const bf16_t* cv; bf16_t* at; bf16_t* bt;
    __device__ __forceinline__ void operator()(const Acc& acc, const Unit& u, int wr, int wc, int fr, int fq) const {
        const int row0 = u.pm * 256 + wr * 64 + fr, ch0 = (u.pn >> 1) * 256 + (u.pn & 1) * 128 + wc * 32 + 8 * fq;
        u32x4 cvr[2][4];
#pragma unroll
        for (int ai = 0; ai < 2; ++ai)
#pragma unroll
            for (int m = 0; m < 4; ++m) cvr[ai][m] = *(const u32x4*)(cv + (size_t)(row0 + ai * 128 + m * 16) * D + ch0);
        f32x4 bx[2], ba[2], ls[2];
#pragma unroll
        for (int n = 0; n < 2; ++n) { bx[n] = *(const f32x4*)(gxb + ch0 + 4 * n); ba[n] = *(const f32x4*)(gab + ch0 + 4 * n); const f32x4 lm = *(const f32x4*)(lam + ch0 + 4 * n);
#pragma unroll
            for (int j = 0; j < 4; ++j) ls[n][j] = -8.f * ((lm[j] > 0.f) ? __logf(1.f + __expf(-lm[j])) : (-lm[j] + __logf(1.f + __expf(lm[j])))); }
#pragma unroll
        for (int ai = 0; ai < 2; ++ai)
#pragma unroll
            for (int m = 0; m < 4; ++m) { const size_t o = (size_t)(row0 + ai * 128 + m * 16) * D + ch0;
                f32x4 cvv[2]; unpack8(cvr[ai][m], cvv[0], cvv[1]); f32x4 av[2], bv[2];
#pragma unroll
                for (int n = 0; n < 2; ++n) { const f32x4 gi = acc[ai][0][m][n], gr = acc[ai][1][m][n];
#pragma unroll
                    for (int j = 0; j < 4; ++j) { const float it = sigmoidf_(gi[j] + bx[n][j]), rt = sigmoidf_(gr[j] + ba[n][j]);
                        const float la = rt * ls[n][j]; av[n][j] = la; bv[n][j] = __builtin_amdgcn_sqrtf(fmaxf(1.f - __expf(2.f * la), 0.f)) * (it * cvv[n][j]); } }
                *(u32x4*)(at + o) = pack8(av[0], av[1]); *(u32x4*)(bt + o) = pack8(bv[0], bv[1]); }
    }
};
struct EpiRKV {
    static constexpr bool PERM = true;
    unsigned char* rkv; bf16_t* lora;
    __device__ __forceinline__ void operator()(const Acc& acc, const Unit& u, int wr, int wc, int fr, int fq) const {
        const int row0 = u.pm * 256 + wr * 64 + fr;
        if (u.pn < 24) {
            bf16_t* dst = (bf16_t*)(rkv + (size_t)(u.pn >> 3) * (64 * MiB)); const int col0 = (u.pn & 7) * 256 + wc * 32 + 8 * fq;
#pragma unroll
            for (int ai = 0; ai < 2; ++ai)
#pragma unroll
                for (int m = 0; m < 4; ++m) { const size_t ro = (size_t)(row0 + ai * 128 + m * 16) * D + col0;
#pragma unroll
                    for (int bj = 0; bj < 2; ++bj) *(u32x4*)(dst + ro + bj * 128) = pack8(acc[ai][bj][m][0], acc[ai][bj][m][1]); }
        } else {
            const int w = u.pn - 24; bf16_t* dst = lora + (size_t)w * T * 256; const int col0 = wc * 32 + 8 * fq;
#pragma unroll
            for (int ai = 0; ai < 2; ++ai)
#pragma unroll
                for (int m = 0; m < 4; ++m) { const size_t ro = (size_t)(row0 + ai * 128 + m * 16) * 256 + col0;
#pragma unroll
                    for (int bj = 0; bj < 2; ++bj) { f32x4 v0 = acc[ai][bj][m][0], v1 = acc[ai][bj][m][1];
                        if (w == 0) {
#pragma unroll
                            for (int j = 0; j < 4; ++j) { v0[j] = tanhf_(v0[j]); v1[j] = tanhf_(v1[j]); }
                        } else if (w == 2) {
#pragma unroll
                            for (int j = 0; j < 4; ++j) { v0[j] = sigmoidf_(v0[j]); v1[j] = sigmoidf_(v1[j]); } }
                        *(u32x4*)(dst + ro + bj * 128) = pack8(v0, v1); } }
        }
    }
};
struct EpiLoraUp {
    static constexpr bool PERM = true;
    const float* w0; const float* a0; float* dec;
    __device__ __forceinline__ void operator()(const Acc& acc, const Unit& u, int wr, int wc, int fr, int fq) const {
        const int w = u.pn >> 3; float* dst = dec + (size_t)w * TD; const float* bias = (w == 0) ? w0 : a0;
        const int row0 = u.pm * 256 + wr * 64 + fr, col0 = (u.pn & 7) * 256 + wc * 32 + 8 * fq;
#pragma unroll
        for (int bj = 0; bj < 2; ++bj) { const int c = col0 + bj * 128; const f32x4 bb0 = *(const f32x4*)(bias + c), bb1 = *(const f32x4*)(bias + c + 4);
#pragma unroll
            for (int ai = 0; ai < 2; ++ai)
#pragma unroll
                for (int m = 0; m < 4; ++m) { f32x4 v0 = acc[ai][bj][m][0], v1 = acc[ai][bj][m][1]; const size_t o = (size_t)(row0 + ai * 128 + m * 16) * D + c;
                    if (w == 0) {
#pragma unroll
                        for (int j = 0; j < 4; ++j) { v0[j] = __expf(-0.6065306597126334f * sigmoidf_(v0[j] + bb0[j])); v1[j] = __expf(-0.6065306597126334f * sigmoidf_(v1[j] + bb1[j])); }
                    } else if (w == 1) {
#pragma unroll
                        for (int j = 0; j < 4; ++j) { v0[j] = sigmoidf_(v0[j] + bb0[j]); v1[j] = sigmoidf_(v1[j] + bb1[j]); }
                    }
                    if (w == 2) *(u32x4*)((bf16_t*)dst + o) = pack8(v0, v1);
                    else { *(f32x4*)(dst + o) = v0; *(f32x4*)(dst + o + 4) = v1; } } }
    }
};
struct EpiUp {
    static constexpr bool PERM = true;
    bf16_t* U;
    __device__ __forceinline__ void operator()(const Acc& acc, const Unit& u, int wr, int wc, int fr, int fq) const {
        const int row0 = u.pm * 256 + wr * 64 + fr, col0 = u.pn * 256 + wc * 32 + 8 * fq;
#pragma unroll
        for (int ai = 0; ai < 2; ++ai)
#pragma unroll
            for (int m = 0; m < 4; ++m) { const size_t ro = (size_t)(row0 + ai * 128 + m * 16) * FF + col0;
#pragma unroll
                for (int bj = 0; bj < 2; ++bj) { f32x4 v0 = acc[ai][bj][m][0], v1 = acc[ai][bj][m][1];
#pragma unroll
                    for (int j = 0; j < 4; ++j) { const float r0 = fmaxf(v0[j], 0.f), r1 = fmaxf(v1[j], 0.f); v0[j] = r0 * r0; v1[j] = r1 * r1; }
                    *(u32x4*)(U + ro + bj * 128) = pack8(v0, v1); } }
    }
};

__device__ __forceinline__ void tr_load(f32x4 (&r)[8], const float* W, int K, int N, int k0, int n0, int lane) {
#pragma unroll
    for (int i = 0; i < 8; ++i) { const int k = k0 + 8 * i + (lane >> 3); r[i] = (k < K) ? __builtin_nontemporal_load((const f32x4*)(W + (size_t)k * N + n0 + (lane & 7) * 4)) : (f32x4){0.f, 0.f, 0.f, 0.f}; }
}
__device__ __forceinline__ void tr_store(const f32x4 (&r)[8], bf16_t* WT, int ldt, int dst_k0, int dst_row0, LAS float* scr, int lane) {
#pragma unroll
    for (int i = 0; i < 8; ++i) { LAS float* d = scr + (8 * i + (lane >> 3)) * 33 + (lane & 7) * 4; d[0] = r[i].x; d[1] = r[i].y; d[2] = r[i].z; d[3] = r[i].w; }
    asm volatile("s_waitcnt lgkmcnt(0)" ::: "memory");
    const int c = lane & 7;
#pragma unroll
    for (int j = 0; j < 4; ++j) { const int n = (lane >> 3) + 8 * j; const LAS float* s = scr + (8 * c) * 33 + n;
        u32x4 o; o.x = cvt_pk_bf16(s[0 * 33], s[1 * 33]); o.y = cvt_pk_bf16(s[2 * 33], s[3 * 33]); o.z = cvt_pk_bf16(s[4 * 33], s[5 * 33]); o.w = cvt_pk_bf16(s[6 * 33], s[7 * 33]);
        *(u32x4*)(WT + (size_t)(dst_row0 + n) * ldt + dst_k0 + 8 * c) = o; }
    asm volatile("s_waitcnt lgkmcnt(0)" ::: "memory");
}

__device__ __forceinline__ bf16_t* w_rg(const Params& P, int j, int which) { return (bf16_t*)(P.ws + OFF_W_RG + (size_t)j * SZ_W_RG + (which == 0 ? 0 : which == 1 ? 16 * MiB : 18 * MiB)); }
__device__ __forceinline__ bf16_t* w_rw(const Params& P, int j, int which) { return (bf16_t*)(P.ws + OFF_W_RW + (size_t)j * SZ_W_RW + (which == 0 ? 0 : which == 1 ? 27 * MiB : 30 * MiB)); }
__device__ __forceinline__ bf16_t* w_mlp(const Params& P, int i, int which) { return (bf16_t*)(P.ws + OFF_W_MLP + (size_t)i * SZ_W_MLP + (which == 0 ? 0 : 32 * MiB)); }

struct JobD { const float* W; bf16_t* WT; int K, N, ldt, nnb, nit, mode, aux; };
constexpr int NJOBS = 36;
__device__ __forceinline__ void get_job(const Params& P, int jid, JobD& d) {
    int src, Kpad; size_t soff; d.mode = 0; d.aux = 0;
    if (jid < 8) { const int i = jid >> 1;
        if (!(jid & 1)) { src = 3; soff = (size_t)i * D * FF; d.K = D; d.N = FF; d.WT = w_mlp(P, i, 0); d.ldt = D; Kpad = D; }
        else { src = 4; soff = (size_t)i * FF * D; d.K = FF; d.N = D; d.WT = w_mlp(P, i, 1); d.ldt = FF; Kpad = FF; }
    } else if (jid < 16) { const int j = (jid - 8) >> 2, q = (jid - 8) & 3;
        if (q == 0) { src = 6; soff = (size_t)j * D * 2 * D; d.K = D; d.N = 2 * D; d.WT = w_rg(P, j, 0); d.ldt = D; Kpad = D; }
        else if (q == 1) { src = 14; soff = (size_t)j * D * D; d.K = D; d.N = D; d.WT = w_rg(P, j, 2); d.ldt = D; Kpad = D; }
        else { src = (q == 2) ? 9 : 11; soff = (size_t)j * 8 * 65536; d.K = 2048; d.N = 256; d.WT = w_rg(P, j, 1); d.ldt = 256; Kpad = 2048; d.mode = 1; d.aux = (q == 2) ? 0 : 128; }
    } else { const int j = (jid - 16) / 10, q = (jid - 16) % 10; d.K = D; d.N = D; d.ldt = D; Kpad = D; d.WT = w_rw(P, j, 0);
        if (q < 3) { src = 16; soff = (size_t)(j * 3 + q) * D * D; d.aux = q * D; }
        else if (q == 3) { src = 18; soff = (size_t)j * D * 96; d.N = 96; d.aux = 6144; }
        else if (q == 4) { src = 21; soff = (size_t)j * D * 96; d.N = 96; d.aux = 6144 + 256; }
        else if (q == 5) { src = 23; soff = (size_t)j * D * 256; d.N = 256; d.aux = 6144 + 512; }
        else if (q == 6) { src = 19; soff = (size_t)j * 96 * D; d.K = 96; d.WT = w_rw(P, j, 1); d.ldt = 256; Kpad = 256; }
        else if (q == 7) { src = 22; soff = (size_t)j * 96 * D; d.K = 96; d.WT = w_rw(P, j, 1); d.ldt = 256; Kpad = 256; d.aux = 2048; }
        else if (q == 8) { src = 24; soff = (size_t)j * 256 * D; d.K = 256; d.WT = w_rw(P, j, 1); d.ldt = 256; Kpad = 256; d.aux = 4096; }
        else { src = 30; soff = (size_t)j * D * D; d.WT = w_rw(P, j, 2); }
    }
    d.W = in_ptr(P, __builtin_amdgcn_readfirstlane(src)) + soff; d.nnb = d.N / 32; d.nit = (Kpad / 64) * d.nnb;
}
__device__ __forceinline__ void convert_jobs(const Params& P, LAS unsigned char* lds, int jlo, int jhi, int gw, int NGW) {
    const int tid = otid(), lane = tid & 63, wave = __builtin_amdgcn_readfirstlane(tid >> 6);
    LAS float* scr = (LAS float*)(lds + wave * 16384);
    int jid = jlo, it = gw; JobD cj; get_job(P, jid, cj);
    while (it >= cj.nit) { it -= cj.nit; if (++jid >= jhi) return; get_job(P, jid, cj); }
    f32x4 r[8]; tr_load(r, cj.W, cj.K, cj.N, (it / cj.nnb) * 64, (it % cj.nnb) * 32, lane);
    for (;;) {
        int njid = jid, nit_ = it + NGW; JobD nj = cj; bool have = true;
        while (nit_ >= nj.nit) { nit_ -= nj.nit; if (++njid >= jhi) { have = false; break; } get_job(P, njid, nj); }
        f32x4 rn[8];
        if (have) tr_load(rn, nj.W, nj.K, nj.N, (nit_ / nj.nnb) * 64, (nit_ % nj.nnb) * 32, lane);
        else {
#pragma unroll
            for (int q = 0; q < 8; ++q) rn[q] = (f32x4){0.f, 0.f, 0.f, 0.f};
        }
        const int k0 = (it / cj.nnb) * 64, n0 = (it % cj.nnb) * 32;
        const int drow = (cj.mode == 1) ? (((k0 >> 8) * 2 + (n0 >> 7)) * 256 + cj.aux + (n0 & 127)) : (cj.aux + n0);
        const int dk0 = (cj.mode == 1) ? (k0 & 255) : k0;
        tr_store(r, cj.WT, cj.ldt, dk0, drow, scr, lane);
        if (!have) break;
#pragma unroll
        for (int q = 0; q < 8; ++q) r[q] = rn[q];
        jid = njid; it = nit_; cj = nj;
    }
}
__device__ __forceinline__ void phase_convert(const Params& P, LAS unsigned char* lds) {
    const int tid = otid(), bid = obid(), wave = __builtin_amdgcn_readfirstlane(tid >> 6);
    const int gw = bid * 8 + wave, NGW = gridDim.x * 8;
    for (int j = 0; j < 2; ++j) {
        u32x4* z0 = (u32x4*)(w_rw(P, j, 0) + (size_t)(6144 + 96) * D); u32x4* z1 = (u32x4*)(w_rw(P, j, 0) + (size_t)(6144 + 256 + 96) * D);
        for (int i = bid * 512 + tid; i < 40960; i += gridDim.x * 512) { z0[i] = (u32x4){0u, 0u, 0u, 0u}; z1[i] = (u32x4){0u, 0u, 0u, 0u}; }
    }
    convert_jobs(P, lds, 0, 4, gw, NGW);
    convert_jobs(P, lds, 8, NJOBS, gw, NGW);
}

template <bool F32OUT> __device__ __forceinline__ void phase_norm(const float* __restrict__ src, const float* __restrict__ g, bf16_t* __restrict__ dstb, float* __restrict__ dstf) {
    const int tid = otid(), lane = tid & 63, gw = obid() * 8 + (tid >> 6), NGW = gridDim.x * 8;
    for (int row = gw; row < T; row += NGW) {
        const f32x4* xr = (const f32x4*)(src + (size_t)row * D) + 2 * lane;
        f32x4 v[8]; float s = 0.f;
#pragma unroll
        for (int j = 0; j < 4; ++j) { v[2 * j] = xr[128 * j]; v[2 * j + 1] = xr[128 * j + 1];
            s += (v[2 * j].x * v[2 * j].x + v[2 * j].y * v[2 * j].y) + (v[2 * j].z * v[2 * j].z + v[2 * j].w * v[2 * j].w);
            s += (v[2 * j + 1].x * v[2 * j + 1].x + v[2 * j + 1].y * v[2 * j + 1].y) + (v[2 * j + 1].z * v[2 * j + 1].z + v[2 * j + 1].w * v[2 * j + 1].w); }
        const float sc = 1.f / sqrtf(wave_sum(s) * (1.f / D) + 1e-6f);
#pragma unroll
        for (int j = 0; j < 4; ++j) { const int i4 = 128 * j + 2 * lane; const f32x4 o0 = v[2 * j] * sc * ((const f32x4*)g)[i4], o1 = v[2 * j + 1] * sc * ((const f32x4*)g)[i4 + 1];
            if (F32OUT) { __builtin_nontemporal_store(o0, (f32x4*)(dstf + (size_t)row * D) + i4); __builtin_nontemporal_store(o1, (f32x4*)(dstf + (size_t)row * D) + i4 + 1); }
            else ((u32x4*)(dstb + (size_t)row * D))[64 * j + lane] = pack8(o0, o1); }
    }
}

__device__ __forceinline__ void phase_mix(const float* __restrict__ src, const float* __restrict__ g, const float* __restrict__ mu, bf16_t* __restrict__ xm) {
    const int tid = otid(), lane = tid & 63, gw = obid() * 8 + (tid >> 6), NGW = gridDim.x * 8;
    for (int row = gw; row < T; row += NGW) {
        const bool hasp = (row % S) != 0;
        const f32x4* x2 = (const f32x4*)(src + (size_t)row * D) + 2 * lane; const f32x4* p2 = x2 - (D / 4);
        const f32x4 z4 = {0.f, 0.f, 0.f, 0.f};
        f32x4 v[8], p[8]; float s = 0.f, sp = 0.f;
#pragma unroll
        for (int j = 0; j < 4; ++j) { v[2 * j] = x2[128 * j]; v[2 * j + 1] = x2[128 * j + 1]; p[2 * j] = hasp ? p2[128 * j] : z4; p[2 * j + 1] = hasp ? p2[128 * j + 1] : z4; }
#pragma unroll
        for (int i = 0; i < 8; ++i) { s += (v[i].x * v[i].x + v[i].y * v[i].y) + (v[i].z * v[i].z + v[i].w * v[i].w); sp += (p[i].x * p[i].x + p[i].y * p[i].y) + (p[i].z * p[i].z + p[i].w * p[i].w); }
        const float sc = 1.f / sqrtf(wave_sum(s) * (1.f / D) + 1e-6f), scp = 1.f / sqrtf(wave_sum(sp) * (1.f / D) + 1e-6f);
#pragma unroll
        for (int j = 0; j < 4; ++j) { const int i4 = 128 * j + 2 * lane;
            const f32x4 g0 = ((const f32x4*)g)[i4], g1 = ((const f32x4*)g)[i4 + 1];
            const f32x4 hn0 = v[2 * j] * sc * g0, hn1 = v[2 * j + 1] * sc * g1, xx0 = p[2 * j] * scp * g0 - hn0, xx1 = p[2 * j + 1] * scp * g1 - hn1;
#pragma unroll
            for (int q = 0; q < 6; ++q) { const f32x4 m0 = ((const f32x4*)(mu + q * D))[i4], m1 = ((const f32x4*)(mu + q * D))[i4 + 1];
                ((u32x4*)(xm + (size_t)q * TD + (size_t)row * D))[64 * j + lane] = pack8(hn0 + xx0 * m0, hn1 + xx1 * m1); }
            __builtin_amdgcn_sched_barrier(0); }
    }
}

__device__ __forceinline__ void phase_conv(const bf16_t* __restrict__ rec, const float* __restrict__ cw, const float* __restrict__ cb, bf16_t* __restrict__ cvb) {
    const int ngrp = (T / 16) * (D / 8);
    for (int gi = obid() * 512 + otid(); gi < ngrp; gi += gridDim.x * 512) {
        const int c8 = gi % (D / 8), r0 = (gi / (D / 8)) * 16; const bool first = (r0 % S) == 0;
        const f32x4 z4 = {0.f, 0.f, 0.f, 0.f};
        f32x4 w0[4], w1[4];
#pragma unroll
        for (int k = 0; k < 4; ++k) { w0[k] = ((const f32x4*)(cw + k * D))[2 * c8]; w1[k] = ((const f32x4*)(cw + k * D))[2 * c8 + 1]; }
        const f32x4 b0 = ((const f32x4*)cb)[2 * c8], b1 = ((const f32x4*)cb)[2 * c8 + 1];
        f32x4 xa0 = z4, xa1 = z4, xb0 = z4, xb1 = z4, xc0 = z4, xc1 = z4;
        if (!first) { unpack8(((const u32x4*)(rec + (size_t)(r0 - 3) * D))[c8], xa0, xa1); unpack8(((const u32x4*)(rec + (size_t)(r0 - 2) * D))[c8], xb0, xb1); unpack8(((const u32x4*)(rec + (size_t)(r0 - 1) * D))[c8], xc0, xc1); }
#pragma unroll
        for (int i = 0; i < 16; ++i) { f32x4 xd0, xd1; unpack8(((const u32x4*)(rec + (size_t)(r0 + i) * D))[c8], xd0, xd1);
            const f32x4 a0 = b0 + w0[0] * xa0 + w0[1] * xb0 + w0[2] * xc0 + w0[3] * xd0, a1 = b1 + w1[0] * xa1 + w1[1] * xb1 + w1[2] * xc1 + w1[3] * xd1;
            ((u32x4*)(cvb + (size_t)(r0 + i) * D))[c8] = pack8(a0, a1);
            xa0 = xb0; xa1 = xb1; xb0 = xc0; xb1 = xc1; xc0 = xd0; xc1 = xd1; }
    }
}

__device__ __forceinline__ void phase_scan1(const bf16_t* __restrict__ at, const bf16_t* __restrict__ bt, float* __restrict__ agga, float* __restrict__ aggh) {
    const int tid = otid();
    for (int item = obid(); item < 256; item += gridDim.x) {
        const int b = item >> 7, chunk = (item >> 1) & 63, half = item & 1, c = half * 1024 + 2 * tid;
        const size_t r0 = (size_t)(b * S + chunk * 64) * D + c;
        f32x2 hh = {0.f, 0.f}, pp = {1.f, 1.f};
#pragma unroll 16
        for (int t = 0; t < 64; ++t) { const size_t o = r0 + (size_t)t * D; const unsigned au = *(const unsigned*)(at + o), bu = *(const unsigned*)(bt + o);
            const f32x2 a2 = {__expf(__uint_as_float(au << 16)), __expf(__uint_as_float(au & 0xffff0000u))}, b2 = {__uint_as_float(bu << 16), __uint_as_float(bu & 0xffff0000u)};
            hh = a2 * hh + b2; pp = pp * a2; }
        const size_t ao = (size_t)(b * 64 + chunk) * D + c; *(f32x2*)(agga + ao) = pp; *(f32x2*)(aggh + ao) = hh;
    }
}
__device__ __forceinline__ void phase_scan2(const bf16_t* __restrict__ at, const bf16_t* __restrict__ bt, const float* __restrict__ agga, const float* __restrict__ aggh, const bf16_t* __restrict__ gate, bf16_t* __restrict__ acta) {
    const int tid = otid();
    for (int item = obid(); item < 256; item += gridDim.x) {
        const int b = item >> 7, chunk = (item >> 1) & 63, half = item & 1, c = half * 1024 + 2 * tid;
        f32x2 hh = {0.f, 0.f};
        for (int k = 0; k < chunk; ++k) { const size_t ao = (size_t)(b * 64 + k) * D + c; hh = *(const f32x2*)(agga + ao) * hh + *(const f32x2*)(aggh + ao); }
        const size_t r0 = (size_t)(b * S + chunk * 64) * D + c;
#pragma unroll 16
        for (int t = 0; t < 64; ++t) { const size_t o = r0 + (size_t)t * D; const unsigned au = __builtin_nontemporal_load((const unsigned*)(at + o)), bu = __builtin_nontemporal_load((const unsigned*)(bt + o)), gu = __builtin_nontemporal_load((const unsigned*)(gate + o));
            const f32x2 a2 = {__expf(__uint_as_float(au << 16)), __expf(__uint_as_float(au & 0xffff0000u))}, b2 = {__uint_as_float(bu << 16), __uint_as_float(bu & 0xffff0000u)};
            hh = a2 * hh + b2;
            *(unsigned*)(acta + o) = cvt_pk_bf16(hh.x * __uint_as_float(gu << 16), hh.y * __uint_as_float(gu & 0xffff0000u)); }
    }
}

__device__ __forceinline__ void phase_recur(const bf16_t* Rg, const bf16_t* Kg, const bf16_t* Vg, const float* DECg, const float* AAg,
                                            const float* k_k, const float* k_a, const float* r_k, float* BON, float* Yg, LAS unsigned char* lds) {
    constexpr int CH = 32, NCH = S / CH;
    constexpr int OFF_V_ = 5 * CH * 64, OFF_YP = OFF_V_ + CH * 16, BUF_F = OFF_YP + CH * 256;
    LAS float* L = (LAS float*)lds;
    const int tid = otid(), wave = tid >> 6, lane = tid & 63;
    for (int it0 = obid(); it0 < 256; it0 += gridDim.x) {
        const int item = (gridDim.x == 256) ? ((it0 & 7) * 32 + (it0 >> 3)) : it0;
        const int b = item >> 7, hh = (item >> 2) & 31, q = item & 3;
        const size_t rowbase = (size_t)b * S;
        const int colh = hh * 64;
        const int ltid = tid - 256, lt = (ltid >> 4) & 15, lj0 = (ltid & 15) * 4, vt = (ltid >> 2) & 31, vi = (ltid & 3) * 4;
        const bool vldr = ltid < 128;
        __syncthreads();
        if (wave >= 4) {
            const f32x4 kkc = *(const f32x4*)(k_k + colh + lj0), kac = *(const f32x4*)(k_a + colh + lj0), rkc = *(const f32x4*)(r_k + colh + lj0);
            f32x4 ga0A = {0, 0, 0, 0}, ga1A = {0, 0, 0, 0}, gd0A = {0, 0, 0, 0}, gd1A = {0, 0, 0, 0}; u32x2 gk0A = {0, 0}, gk1A = {0, 0}, gr0A = {0, 0}, gr1A = {0, 0}, gvrA = {0, 0};
            f32x4 ga0B = {0, 0, 0, 0}, ga1B = {0, 0, 0, 0}, gd0B = {0, 0, 0, 0}, gd1B = {0, 0, 0, 0}; u32x2 gk0B = {0, 0}, gk1B = {0, 0}, gr0B = {0, 0}, gr1B = {0, 0}, gvrB = {0, 0};
#define RC_GLOAD(X, ch) do { if ((ch) < NCH) { const size_t go = (rowbase + (size_t)(ch) * CH + lt) * D + colh + lj0, go1 = go + (size_t)16 * D; \
                gk0##X = *(const u32x2*)(Kg + go); gr0##X = *(const u32x2*)(Rg + go); ga0##X = *(const f32x4*)(AAg + go); gd0##X = *(const f32x4*)(DECg + go); \
                gk1##X = *(const u32x2*)(Kg + go1); gr1##X = *(const u32x2*)(Rg + go1); ga1##X = *(const f32x4*)(AAg + go1); gd1##X = *(const f32x4*)(DECg + go1); \
                if (vldr) gvr##X = *(const u32x2*)(Vg + (rowbase + (size_t)(ch) * CH + vt) * D + colh + q * 16 + vi); } } while (0)
#define RC_LW1(B, kraw, rraw, av, dv, tt, chk) do { const f32x4 kf = unpack4(kraw), rf = unpack4(rraw); f32x4 nn = kf * kkc; \
                const float ss = row16_allsum((nn.x * nn.x + nn.y * nn.y) + (nn.z * nn.z + nn.w * nn.w)); \
                const float inv = __builtin_amdgcn_rcpf(fmaxf(__builtin_amdgcn_sqrtf(ss), 1e-12f)); nn = nn * inv; \
                const f32x4 one = {1.f, 1.f, 1.f, 1.f}; const int lo = (tt) * 64 + lj0; const f32x4 km = kf * (one + (av - one) * kac), bt_ = rf * km * rkc; \
                const float bs = row16_allsum((bt_.x + bt_.y) + (bt_.z + bt_.w)); \
                if (q == 0 && (ltid & 15) == 0) BON[(rowbase + (size_t)(chk) * CH + (tt)) * 32 + hh] = bs;     \
                *(LAS f32x4*)(B + 0 * CH * 64 + lo) = dv; *(LAS f32x4*)(B + 1 * CH * 64 + lo) = nn; *(LAS f32x4*)(B + 2 * CH * 64 + lo) = nn * av; \
                *(LAS f32x4*)(B + 3 * CH * 64 + lo) = km; *(LAS f32x4*)(B + 4 * CH * 64 + lo) = rf; } while (0)
#define RC_LWRITE(X, buf, chk) do { LAS float* B = L + (buf) * BUF_F; RC_LW1(B, gk0##X, gr0##X, ga0##X, gd0##X, lt, chk); RC_LW1(B, gk1##X, gr1##X, ga1##X, gd1##X, lt + 16, chk); \
                if (vldr) *(LAS f32x4*)(B + OFF_V_ + vt * 16 + vi) = unpack4(gvr##X); } while (0)
#define RC_FLUSH(ch, buf) do { if (wave >= 6) { const LAS float* Bp = L + (buf) * BUF_F + OFF_YP + (wave - 6) * 16 * 256 + lane * 4; \
                float* yo = Yg + (rowbase + (size_t)(ch) * CH + (wave - 6) * 16) * D + colh + q * 16 + (lane >> 2); \
                _Pragma("unroll") for (int _i = 0; _i < 16; ++_i) { const f32x4 p4 = *(const LAS f32x4*)(Bp + _i * 256); float sq = (p4.x + p4.y) + (p4.z + p4.w); \
                    sq += dpp_f<0xB1>(sq); sq += dpp_f<0x4E>(sq); if ((lane & 3) == 0) yo[(size_t)_i * D] = sq; } } } while (0)
            RC_GLOAD(A, 0); RC_LWRITE(A, 0, 0); RC_GLOAD(A, 1); RC_GLOAD(B, 2);
            __syncthreads();
            for (int ch = 0; ch < NCH; ch += 2) {
                RC_LWRITE(A, 1, ch + 1); RC_GLOAD(A, ch + 3);
                if (ch >= 1) RC_FLUSH(ch - 1, 1);
                __syncthreads();
                if (ch + 2 < NCH) { RC_LWRITE(B, 0, ch + 2); RC_GLOAD(B, ch + 4); }
                RC_FLUSH(ch, 0);
                __syncthreads();
            }
            RC_FLUSH(NCH - 1, 1);
#undef RC_GLOAD
#undef RC_LW1
#undef RC_LWRITE
#undef RC_FLUSH
        } else {
            __syncthreads();
            const int rl = wave * 4 + (lane >> 4), js = lane & 15;
            f32x2 sa = {0.f, 0.f}, sb = {0.f, 0.f};
            for (int ch = 0; ch < NCH; ++ch) {
                LAS float* B = L + (ch & 1) * BUF_F;
                const LAS float* pj = B + js * 4; const LAS float* pv = B + OFF_V_ + rl; LAS float* py = B + OFF_YP + rl * 16 + js;
                f32x4 w4 = *(const LAS f32x4*)(pj + 0 * CH * 64), k4 = *(const LAS f32x4*)(pj + 1 * CH * 64), b4 = *(const LAS f32x4*)(pj + 2 * CH * 64);
                f32x4 m4 = *(const LAS f32x4*)(pj + 3 * CH * 64), r4 = *(const LAS f32x4*)(pj + 4 * CH * 64); float v = pv[0];
#pragma unroll
                for (int t = 0; t < CH; ++t) {
                    const int tn = (t + 1 < CH) ? t + 1 : t;
                    const f32x4 w4n = *(const LAS f32x4*)(pj + 0 * CH * 64 + tn * 64), k4n = *(const LAS f32x4*)(pj + 1 * CH * 64 + tn * 64), b4n = *(const LAS f32x4*)(pj + 2 * CH * 64 + tn * 64);
                    const f32x4 m4n = *(const LAS f32x4*)(pj + 3 * CH * 64 + tn * 64), r4n = *(const LAS f32x4*)(pj + 4 * CH * 64 + tn * 64); const float vn = pv[tn * 16];
                    const f32x2 pk = sa * k4.xy + sb * k4.zw;
                    const float p = row16_allsum(pk.x + pk.y);
                    const f32x2 pp = {p, p}, vv = {v, v};
                    sa = sa * w4.xy + (vv * m4.xy - pp * b4.xy);
                    sb = sb * w4.zw + (vv * m4.zw - pp * b4.zw);
                    const f32x2 yk = sa * r4.xy + sb * r4.zw;
                    py[t * 256] = yk.x + yk.y;
                    w4 = w4n; k4 = k4n; b4 = b4n; m4 = m4n; r4 = r4n; v = vn;
                }
                __syncthreads();
            }
        }
    }
}

__device__ __forceinline__ float oct_allsum(float x) {
    x += dpp_f<0x141>(x); x += dpp_f<0x4E>(x); x += dpp_f<0xB1>(x); return x;
}
__device__ __forceinline__ void phase_gn(const float* __restrict__ Yg, const bf16_t* __restrict__ Vg, const bf16_t* __restrict__ GGg, const float* __restrict__ BON,
                                         const float* __restrict__ ln_g, const float* __restrict__ ln_b, bf16_t* __restrict__ acta) {
    const int tid = otid(), lane = tid & 63, gw = obid() * 8 + (tid >> 6), NGW = gridDim.x * 8;
    for (int row = gw; row < T; row += NGW) {
        const size_t ro = (size_t)row * D;
#pragma unroll 2
        for (int j = 0; j < 4; ++j) { const int c = (64 * j + lane) * 8; const size_t o = ro + c;
            const f32x4 y0 = __builtin_nontemporal_load((const f32x4*)(Yg + o)), y1 = __builtin_nontemporal_load((const f32x4*)(Yg + o + 4));
            f32x4 v0, v1, g0, g1;
            unpack8(__builtin_nontemporal_load((const u32x4*)(Vg + o)), v0, v1); unpack8(__builtin_nontemporal_load((const u32x4*)(GGg + o)), g0, g1);
            const float sb = BON[(size_t)row * 32 + (c >> 6)];
            const f32x4 lg0 = *(const f32x4*)(ln_g + c), lg1 = *(const f32x4*)(ln_g + c + 4), lb0 = *(const f32x4*)(ln_b + c), lb1 = *(const f32x4*)(ln_b + c + 4);
            float sm = ((y0.x + y0.y) + (y0.z + y0.w)) + ((y1.x + y1.y) + (y1.z + y1.w));
            sm = oct_allsum(sm);
            const float mean = sm * (1.f / 64.f); const f32x4 d0 = y0 - mean, d1 = y1 - mean;
            float sv = ((d0.x * d0.x + d0.y * d0.y) + (d0.z * d0.z + d0.w * d0.w)) + ((d1.x * d1.x + d1.y * d1.y) + (d1.z * d1.z + d1.w * d1.w)); sv = oct_allsum(sv);
            const float rstd = 1.f / sqrtf(sv * (1.f / 64.f) + 64e-5f);
            *(u32x4*)(acta + o) = pack8((d0 * rstd * lg0 + lb0 + v0 * sb) * g0, (d1 * rstd * lg1 + lb1 + v1 * sb) * g1); }
    }
}

__device__ __forceinline__ void run_phase(const Params& P, int ph, LAS unsigned char* lds) {
    unsigned char* ws = P.ws;
    float* H0 = (float*)(ws + OFF_H); float* H1 = (float*)(ws + OFF_H2); bf16_t* ACTA = (bf16_t*)(ws + OFF_ACTA);
    const int G = gridDim.x, c = obid();
    if (ph == 0) { if constexpr (KEN(20)) { phase_convert(P, lds); phase_norm<false>(in_ptr(P, 0), in_ptr(P, 1), ACTA, nullptr); } return; }
    if (ph == 39) { if constexpr (KEN(21)) phase_norm<true>(H1, in_ptr(P, 5), nullptr, P.out); return; }
    const int p = ph - 1, pair = p / 19, r = p % 19;
    const bool is_rg = r < 10; const int layer = 2 * pair + (is_rg ? 0 : 1), sub = is_rg ? r : r - 10, j = pair;
    const float* hsrc = (layer == 0) ? in_ptr(P, 0) : H1;
    int kind;
    if (is_rg) kind = sub; else kind = (sub < 5) ? 10 + sub : sub + 1;
    switch (kind) {
    case 0: if constexpr (KEN(0)) phase_norm<false>(hsrc, in_ptr(P, 1) + (size_t)layer * D, ACTA, nullptr); break;
    case 7: if constexpr (KEN(0)) phase_norm<false>(H0, in_ptr(P, 2) + (size_t)layer * D, ACTA, nullptr); break;
    case 1: if constexpr (KEN(1)) { pg8::Gemm g{ACTA, w_rg(P, j, 0), T, 2 * D, D, D, D}; pg8::Order<0> So; So.init(T, 2 * D, G, c);
        EpiInProj E{(bf16_t*)(ws + OFF_GATE), (bf16_t*)(ws + OFF_REC)}; pg8::gemm_phase(lds, g, So, E); break; }
    case 2: if constexpr (KEN(2)) phase_conv((const bf16_t*)(ws + OFF_REC), in_ptr(P, 7) + (size_t)j * 4 * D, in_ptr(P, 8) + (size_t)j * D, (bf16_t*)(ws + OFF_CVB)); break;
    case 3: if constexpr (KEN(3)) { pg8::Gemm g{(const bf16_t*)(ws + OFF_CVB), w_rg(P, j, 1), T, 2 * D, 256, D, 256}; pg8::Order<1> So; So.init(T, 2 * D, G, c);
        EpiGates E{in_ptr(P, 10) + (size_t)j * D, in_ptr(P, 12) + (size_t)j * D, in_ptr(P, 13) + (size_t)j * D, (const bf16_t*)(ws + OFF_CVB), (bf16_t*)(ws + OFF_AT), (bf16_t*)(ws + OFF_BT)};
        pg8::gemm_phase(lds, g, So, E); break; }
    case 4: if constexpr (KEN(4)) phase_scan1((const bf16_t*)(ws + OFF_AT), (const bf16_t*)(ws + OFF_BT), (float*)(ws + OFF_AGGA), (float*)(ws + OFF_AGGH)); break;
    case 5: if constexpr (KEN(5)) phase_scan2((const bf16_t*)(ws + OFF_AT), (const bf16_t*)(ws + OFF_BT), (const float*)(ws + OFF_AGGA), (const float*)(ws + OFF_AGGH), (const bf16_t*)(ws + OFF_GATE), ACTA); break;
    case 6: case 9: if constexpr (KEN(6)) { const bool down = (kind == 9);
        const bf16_t* A = down ? (const bf16_t*)(ws + OFF_U) : ACTA; const bf16_t* Bt = down ? w_mlp(P, layer, 1) : (is_rg ? w_rg(P, j, 2) : w_rw(P, j, 2));
        const int K = down ? FF : D; pg8::Gemm g{A, Bt, T, D, K, K, K}; pg8::Order<0> So; So.init(T, D, G, c);
        EpiResidual E{down ? (const float*)H0 : hsrc, down ? H1 : H0}; pg8::gemm_phase(lds, g, So, E); break; }
    case 8: if constexpr (KEN(8)) { pg8::Gemm g{ACTA, w_mlp(P, layer, 0), T, FF, D, D, D}; pg8::Order<0> So; So.init(T, FF, G, c);
        EpiUp E{(bf16_t*)(ws + OFF_U)}; pg8::gemm_phase(lds, g, So, E); break; }
    case 10: if constexpr (KEN(10)) phase_mix(hsrc, in_ptr(P, 1) + (size_t)layer * D, in_ptr(P, 15) + (size_t)j * 6 * D, (bf16_t*)(ws + OFF_XM)); break;
    case 11: if constexpr (KEN(11)) { pg8::Gemm g{(const bf16_t*)(ws + OFF_XM), w_rw(P, j, 0), T, 6912, D, D, D}; pg8::Order<2> So; So.init(T, 6912, G, c);
        EpiRKV E{ws + OFF_R, (bf16_t*)(ws + OFF_LORA)}; pg8::gemm_phase(lds, g, So, E);
        { const int nfull = 864 % G; if (nfull != 0 && c >= nfull) { const int wv = __builtin_amdgcn_readfirstlane(otid() >> 6); convert_jobs(P, lds, 4 + 2 * j, 6 + 2 * j, (c - nfull) * 8 + wv, (G - nfull) * 8); }
          else if (nfull == 0) { const int wv = __builtin_amdgcn_readfirstlane(otid() >> 6); convert_jobs(P, lds, 4 + 2 * j, 6 + 2 * j, c * 8 + wv, G * 8); } }
        break; }
    case 12: if constexpr (KEN(12)) { pg8::Gemm g{(const bf16_t*)(ws + OFF_LORA), w_rw(P, j, 1), T, 6144, 256, 256, 256}; pg8::Order<3> So; So.init(T, 6144, G, c);
        EpiLoraUp E{in_ptr(P, 17) + (size_t)j * D, in_ptr(P, 20) + (size_t)j * D, (float*)(ws + OFF_DEC)}; pg8::gemm_phase(lds, g, So, E); break; }
    case 13: if constexpr (KEN(13)) phase_recur((const bf16_t*)(ws + OFF_R), (const bf16_t*)(ws + OFF_K), (const bf16_t*)(ws + OFF_V), (const float*)(ws + OFF_DEC), (const float*)(ws + OFF_AA),
                         in_ptr(P, 25) + (size_t)j * D, in_ptr(P, 26) + (size_t)j * D, in_ptr(P, 27) + (size_t)j * D, (float*)(ws + OFF_BON), (float*)(ws + OFF_YREC), lds); break;
    case 14: if constexpr (KEN(14)) phase_gn((const float*)(ws + OFF_YREC), (const bf16_t*)(ws + OFF_V), (const bf16_t*)(ws + OFF_GG), (const float*)(ws + OFF_BON),
                      in_ptr(P, 28) + (size_t)j * D, in_ptr(P, 29) + (size_t)j * D, ACTA); break;
    default: break;
    }
}

#define XB_TMO      128
#define XB_XCNT(j)  (256  + 64 * (j))
#define XB_XSUB(j)  (1280 + 64 * (j))
#define XB_XGEN(j)  (2304 + 64 * (j))
#define XB_TOP      3328
#define XB_TOPGEN   3392
#define XCD_BAR_WORDS 3456
#define XB_SPIN_CAP (1u << 20)
__device__ __forceinline__ unsigned xb_ld(unsigned* p)              { return __hip_atomic_load(p, __ATOMIC_RELAXED, __HIP_MEMORY_SCOPE_AGENT); }
__device__ __forceinline__ unsigned xb_add(unsigned* p, unsigned v) { return __hip_atomic_fetch_add(p, v, __ATOMIC_RELAXED, __HIP_MEMORY_SCOPE_AGENT); }
__device__ __forceinline__ unsigned xb_xcc_id() { return (unsigned)__builtin_amdgcn_s_getreg((3 << 11) | 20) & 0xFu; }
#define XB_SPIN(cond, bar) do { unsigned _sp = 0; while (cond) { __builtin_amdgcn_s_sleep(1); \
    if ((++_sp & 255u) == 0u) { if (xb_ld(&(bar)[XB_TMO])) break; if (_sp > XB_SPIN_CAP) { atomicAdd(&(bar)[XB_TMO], 1u); break; } } } } while (0)
struct XcdBarrier { unsigned* bar; unsigned x; volatile LAS unsigned* st; };
__device__ __forceinline__ XcdBarrier xcd_barrier_post(unsigned* bar, volatile LAS unsigned* st) {
    XcdBarrier b; b.bar = bar; b.x = xb_xcc_id(); b.st = st;
    if (threadIdx.x == 0) (void)xb_add(&bar[XB_XCNT(b.x)], 1u);
    return b;
}
__device__ __forceinline__ void xcd_barrier_complete(unsigned* bar, unsigned x, unsigned& nloc, unsigned& nx) {
    const unsigned G = gridDim.x * gridDim.y * gridDim.z;
    unsigned sum, cnt, mine, sp = 0u;
    for (;;) {
        sum = 0u; cnt = 0u; mine = 0u;
#pragma unroll
        for (unsigned j = 0; j < 16; ++j) { const unsigned c = xb_ld(&bar[XB_XCNT(j)]); sum += c; cnt += (c > 0u) ? 1u : 0u; mine = (j == x) ? c : mine; }
        if (sum == G) break;
        __builtin_amdgcn_s_sleep(1);
        if ((++sp & 255u) == 0u) { if (xb_ld(&bar[XB_TMO])) break; if (sp > XB_SPIN_CAP) { atomicAdd(&bar[XB_TMO], 1u); break; } }
    }
    nloc = mine > 0u ? mine : 1u; nx = cnt > 0u ? cnt : 1u;
}
__device__ __forceinline__ void xcd_barrier(const XcdBarrier& b) {
    asm volatile("s_waitcnt vmcnt(0)" ::: "memory");
    __syncthreads();
    if (threadIdx.x == 0) {
        unsigned* bar = b.bar;
        __builtin_amdgcn_s_waitcnt(0);
        unsigned nloc = b.st[0], nx = b.st[1];
        if (nloc == 0u) { xcd_barrier_complete(bar, b.x, nloc, nx); b.st[0] = nloc; b.st[1] = nx; }
        const unsigned old = xb_add(&bar[XB_XSUB(b.x)], 1u);
        const unsigned gen = old / nloc;
        if (old + 1u == (gen + 1u) * nloc) {
            __builtin_amdgcn_fence(__ATOMIC_RELEASE, "agent");
            asm volatile("s_waitcnt vmcnt(0)" ::: "memory");
            const unsigned og = xb_add(&bar[XB_TOP], 1u);
            const unsigned tg = og / nx;
            if (og + 1u == (tg + 1u) * nx) xb_add(&bar[XB_TOPGEN], 1u);
            else XB_SPIN(xb_ld(&bar[XB_TOPGEN]) == tg, bar);
            __builtin_amdgcn_fence(__ATOMIC_ACQUIRE, "agent");
            xb_add(&bar[XB_XGEN(b.x)], 1u);
            asm volatile("s_waitcnt vmcnt(0)" ::: "memory");
        } else {
            XB_SPIN(xb_ld(&bar[XB_XGEN(b.x)]) == gen, bar);
            __builtin_amdgcn_fence(__ATOMIC_ACQUIRE, "agent");
            asm volatile("s_waitcnt vmcnt(0)" ::: "memory");
        }
    }
    __syncthreads();
}

constexpr int N_PHASES = 40;

__global__ void __launch_bounds__(512, 2) mega(Params P) {
    extern __shared__ __attribute__((aligned(16))) unsigned char shm[];
    LAS unsigned char* lds = (LAS unsigned char*)shm;
    cg::grid_group grid = cg::this_grid();
    volatile LAS unsigned* st = (volatile LAS unsigned*)(lds + LDS_ST_OFF);
    if (threadIdx.x == 0) { st[0] = 0u; st[1] = 0u; }
    __syncthreads();
    const XcdBarrier xb = xcd_barrier_post((unsigned*)(P.ws + OFF_BAR), st);
    bool first_seam = true;
    for (int ph = P.ph_lo; ph < P.ph_hi; ++ph) {
        if (ph == 1) continue;
        int nrep = 1;
        if (REPMASK != 0u) {
            int kind; if (ph == 0) kind = 20; else if (ph == 39) kind = 21; else { const int r = (ph - 1) % 19; kind = r < 10 ? r : (r - 10 < 5 ? r : r - 9); }
            if ((REPMASK >> kind) & 1u) nrep = 2;
        }
        for (int rep = 0; rep < nrep; ++rep) {
            if (ph > P.ph_lo || rep > 0) {
                if (first_seam) { grid.sync(); first_seam = false; }
                else xcd_barrier(xb);
            }
            run_phase(P, ph, lds);
        }
    }
}

extern "C" void kernel_launch(void* const* d_in, const int* in_sizes, int n_in, void* d_out, int out_size, void* d_ws, size_t ws_size, hipStream_t stream) {
    static int grid = 0;
    if (grid == 0) {
        if (n_in != 31 || in_sizes[0] != T * D || out_size != T * D || ws_size < WS_END) {
            fprintf(stderr, "kernel_launch: unexpected shapes: n_in %d in0 %d out %d ws %zu (need %zu)\n", n_in, n_in > 0 ? in_sizes[0] : -1, out_size, ws_size, (size_t)WS_END); grid = -1; return; }
        int dev = 0, cus = 0, per_cu = 0;
        hipGetDevice(&dev); hipDeviceGetAttribute(&cus, hipDeviceAttributeMultiprocessorCount, dev);
        if (hipFuncSetAttribute((const void*)mega, hipFuncAttributeMaxDynamicSharedMemorySize, LDS_BYTES) != hipSuccess) { fprintf(stderr, "kernel_launch: hipFuncSetAttribute failed\n"); grid = -1; return; }
        if (hipOccupancyMaxActiveBlocksPerMultiprocessor(&per_cu, (const void*)mega, 512, LDS_BYTES) != hipSuccess || per_cu < 1) { fprintf(stderr, "kernel_launch: occupancy query says %d\n", per_cu); per_cu = 1; }
        (void)hipGetLastError();
        grid = cus * per_cu;
    }
    if (grid < 0) return;
    Params p{};
    for (int i = 0; i < 31; ++i) p.in[i] = (const float*)d_in[i];
    p.out = (float*)d_out; p.ws = (unsigned char*)d_ws;
    if (hipMemsetAsync((char*)d_ws + OFF_BAR, 0, XCD_BAR_WORDS * 4, stream) != hipSuccess) { fprintf(stderr, "kernel_launch: memset of the barrier words failed\n"); return; }
#if N_LAUNCH_PER_PHASE
    for (int ph = 0; ph < N_PHASES; ++ph) { p.ph_lo = ph; p.ph_hi = ph + 1; hipLaunchKernelGGL(mega, dim3(grid), dim3(512), LDS_BYTES, stream, p); }
#else
    p.ph_lo = 0; p.ph_hi = N_PHASES;
    void* args[] = {&p};
    hipError_t e = hipLaunchCooperativeKernel((const void*)mega, dim3(grid), dim3(512), args, LDS_BYTES, stream);
    if (e != hipSuccess) fprintf(stderr, "cooperative launch failed: %s (grid %d)\n", hipGetErrorString(e), grid);
#endif
}
```
